# Optimizing an MI355X kernel written in HIP

```python
import jax, jax.numpy as jnp
from jax import lax
import numpy as np


D_MODEL = 2048
BATCH = 32
SEQ = 256
DEPTH = 2
DEC_BATCH = 8
DEC_SEQ = 2048
PAST_LEN = 256

GRID_W = 64
BRANCH = D_MODEL // 2
N_SLICES = 6
N_DIR = 2
N_EVEN = (DEPTH + 1) // 2
N_ODD = DEPTH // 2
LRU_HEADS = 8
LRU_HEAD_DIM = BRANCH // LRU_HEADS
LRU_CONV = 4
LRU_C = 8.0
RET_HEADS = 8
RET_HEAD_DIM = BRANCH // RET_HEADS
RET_CHUNK = 128
FOURIER_GROUPS = 4
SCONV = 3
ROPE_BASE = 10000.0
EPS = 1e-6

kernel_name = 'hybrid_lru_retention_fnet_shortconv_prefix_dit'


def rmsnorm(x, g):
    xf = x.astype(jnp.float32)
    y = xf * lax.rsqrt(jnp.mean(xf * xf, axis=-1, keepdims=True) + EPS)
    return (y * g.astype(jnp.float32)).astype(x.dtype)


def modulation(cond, ada_w, ada_b):
    m = jax.nn.silu(cond) @ ada_w + ada_b
    shift, scale, gate = jnp.split(m[:, None, :], 3, axis=-1)
    return shift, scale, gate


def dwconv(x, w, pad_lo, pad_hi):
    return lax.conv_general_dilated(
        x, w.astype(x.dtype)[:, None, :], window_strides=(1,), padding=[(pad_lo, pad_hi)],
        dimension_numbers=('NWC', 'WIO', 'NWC'), feature_group_count=x.shape[-1])


def grid_rope(n_tokens):
    rows = n_tokens // GRID_W
    row = jnp.repeat(jnp.arange(rows, dtype=jnp.float32), GRID_W)
    col = jnp.tile(jnp.arange(GRID_W, dtype=jnp.float32), rows)
    n_freq = RET_HEAD_DIM // 4
    freqs = ROPE_BASE ** (-jnp.arange(n_freq, dtype=jnp.float32) / n_freq)
    ang = jnp.concatenate([row[:, None] * freqs, col[:, None] * freqs], axis=-1)
    return jnp.cos(ang), jnp.sin(ang)


def apply_rope(x, cos, sin):
    x1, x2 = jnp.split(x, 2, axis=-1)
    cs, sn = cos[:, None, :], sin[:, None, :]
    return jnp.concatenate([x1 * cs - x2 * sn, x1 * sn + x2 * cs], axis=-1)


def linear_scan(a, b, h0):
    def comb(l, r):
        return l[0] * r[0], r[0] * l[1] + r[1]
    a_cum, h = lax.associative_scan(comb, (a, b), axis=1)
    return h + a_cum * h0[:, None, :]


def rglru_dir(u, h0, lam, w_r, b_r, w_i, b_i):
    bsz, t, w = u.shape
    uh = u.reshape(bsz, t, LRU_HEADS, LRU_HEAD_DIM)
    r = jax.nn.sigmoid(jnp.einsum('bthi,hij->bthj', uh, w_r).reshape(bsz, t, w) + b_r)
    i = jax.nn.sigmoid(jnp.einsum('bthi,hij->bthj', uh, w_i).reshape(bsz, t, w) + b_i)
    log_a = -LRU_C * r * jax.nn.softplus(-lam.astype(jnp.float32))
    a = jnp.exp(log_a)
    norm_in = jnp.sqrt(-jnp.expm1(2.0 * log_a))
    h = linear_scan(a, norm_in * (i * u), h0)
    return h, h[:, -1]


def lru_mixer(xa, h0s, conv_w, conv_b, lam, w_r, b_r, w_i, b_i):
    u = (dwconv(xa, conv_w, 2, 1) + conv_b).astype(jnp.float32)
    h0s = h0s.astype(jnp.float32)
    hf, sf = rglru_dir(u, h0s[:, 0], lam[0], w_r[0], b_r[0], w_i[0], b_i[0])
    hb, sb = rglru_dir(jnp.flip(u, 1), h0s[:, 1], lam[1], w_r[1], b_r[1], w_i[1], b_i[1])
    return hf + jnp.flip(hb, 1), jnp.stack([sf, sb], axis=1)


def retention_dir(q, k, v, s0, log_g):
    bsz, nh, t, d = q.shape
    n_chunks = t // RET_CHUNK
    idx = jnp.arange(RET_CHUNK, dtype=jnp.float32)
    diff = idx[:, None] - idx[None, :]
    mask = jnp.where(diff >= 0, jnp.exp(log_g[:, None, None] * jnp.maximum(diff, 0.0)), 0.0)
    q_dec = jnp.exp(log_g[:, None] * (idx + 1.0))[..., None]
    k_dec = jnp.exp(log_g[:, None] * (RET_CHUNK - 1.0 - idx))[..., None]
    chunk_dec = jnp.exp(log_g * RET_CHUNK)[:, None, None]

    def to_chunks(z):
        return z.reshape(bsz, nh, n_chunks, RET_CHUNK, d).transpose(2, 0, 1, 3, 4)

    def step(s, qkv):
        qi, ki, vi = qkv
        scores = jnp.einsum('bhid,bhjd->bhij', qi, ki) * mask
        o = jnp.einsum('bhij,bhje->bhie', scores, vi) + jnp.einsum('bhid,bhde->bhie', qi * q_dec, s)
        s = s * chunk_dec + jnp.einsum('bhjd,bhje->bhde', ki * k_dec, vi)
        return s, o

    s_fin, oc = lax.scan(step, s0, (to_chunks(q), to_chunks(k), to_chunks(v)))
    o = oc.transpose(1, 2, 0, 3, 4).reshape(bsz, nh, t, d)
    return o, s_fin


def retention_mixer(q, k, v, s0s, ret_decay, ret_norm_g, rope):
    bsz, t, w = q.shape
    shp = (bsz, t, RET_HEADS, RET_HEAD_DIM)
    qh = q.astype(jnp.float32).reshape(shp)
    kh = k.astype(jnp.float32).reshape(shp) * (RET_HEAD_DIM ** -0.5)
    vh = v.astype(jnp.float32).reshape(shp)
    if rope is not None:
        qh = apply_rope(qh, *rope)
        kh = apply_rope(kh, *rope)
    qh, kh, vh = (z.transpose(0, 2, 1, 3) for z in (qh, kh, vh))
    log_g = jax.nn.log_sigmoid(ret_decay.astype(jnp.float32))
    s0s = s0s.astype(jnp.float32)
    of, sf = retention_dir(qh, kh, vh, s0s[:, 0], log_g[0])
    ob, sb = retention_dir(jnp.flip(qh, 2), jnp.flip(kh, 2), jnp.flip(vh, 2), s0s[:, 1], log_g[1])
    o = (of + jnp.flip(ob, 2)).transpose(0, 2, 1, 3)
    o = o * lax.rsqrt(jnp.mean(o * o, axis=-1, keepdims=True) + EPS)
    o = o.reshape(bsz, t, w) * ret_norm_g.astype(jnp.float32)
    return o, jnp.stack([sf, sb], axis=1)


def fourier_mixer(u):
    bsz, t, w = u.shape
    ug = u.astype(jnp.float32).reshape(bsz, t, FOURIER_GROUPS, w // FOURIER_GROUPS)
    y = jnp.fft.fftn(ug, axes=(1, 3), norm='ortho').real
    return y.reshape(bsz, t, w)


def shortconv_mixer(gb, gc, xd, conv_w):
    return (gb * dwconv(gc * xd, conv_w, 1, 1)).astype(jnp.float32)


def layer_lru_retention(x, cond, h0_lru, s0_ret, rope, norm_g, ada_w, ada_b, w_in, w_out,
                        conv_w, conv_b, lam, w_r, b_r, w_i, b_i, ret_decay, ret_norm_g):
    shift, scale, gate = modulation(cond, ada_w, ada_b)
    h = rmsnorm(x, norm_g) * (1.0 + scale) + shift
    xa, ga, q, k, v, gb = jnp.split(h @ w_in, N_SLICES, axis=-1)
    ya, s_lru = lru_mixer(xa, h0_lru, conv_w, conv_b, lam, w_r, b_r, w_i, b_i)
    yb, s_ret = retention_mixer(q, k, v, s0_ret, ret_decay, ret_norm_g, rope)
    y = jnp.concatenate([ya * jax.nn.silu(ga.astype(jnp.float32)),
                         yb * jax.nn.silu(gb.astype(jnp.float32))], axis=-1).astype(x.dtype)
    return x + gate * (y @ w_out), s_lru, s_ret


def layer_fourier_shortconv(x, cond, norm_g, ada_w, ada_b, w_in, w_out, conv_w):
    shift, scale, gate = modulation(cond, ada_w, ada_b)
    h = rmsnorm(x, norm_g) * (1.0 + scale) + shift
    xc, gc, bd, cd, xd, gd = jnp.split(h @ w_in, N_SLICES, axis=-1)
    yc = fourier_mixer(xc)
    yd = shortconv_mixer(bd, cd, xd, conv_w)
    y = jnp.concatenate([yc * jax.nn.silu(gc.astype(jnp.float32)),
                         yd * jax.nn.silu(gd.astype(jnp.float32))], axis=-1).astype(x.dtype)
    return x + gate * (y @ w_out)


def setup_inputs(seed: int = 0) -> dict:
    key = jax.random.key(seed)
    ks = iter(jax.random.split(key, 32))
    f32 = jnp.float32

    def nrm(shape, s):
        return s * jax.random.normal(next(ks), shape, f32)

    W, D = BRANCH, D_MODEL
    x_prompt = nrm((BATCH, SEQ, D), 1.0)
    x_sample = nrm((DEC_BATCH, DEC_SEQ, D), 1.0)
    state_lru = nrm((DEC_BATCH, N_EVEN, N_DIR, W), 0.5)
    state_ret = nrm((DEC_BATCH, N_EVEN, N_DIR, RET_HEADS, RET_HEAD_DIM, RET_HEAD_DIM), 1.0)
    c = nrm((DEC_BATCH, D), 1.0)
    c_ctx = nrm((D,), 1.0)
    norm_g = 1.0 + nrm((DEPTH, D), 0.02)
    ada_w = nrm((DEPTH, D, 3 * D), 0.5 * D ** -0.5)
    ada_b = nrm((DEPTH, 3 * D), 0.01)
    w_in = nrm((DEPTH, D, N_SLICES * W), D ** -0.5)
    w_out = nrm((DEPTH, 2 * W, D), (2 * W) ** -0.5)
    lru_conv_w = nrm((N_EVEN, LRU_CONV, W), LRU_CONV ** -0.5)
    lru_conv_b = nrm((N_EVEN, W), 0.01)
    a_c = jax.random.uniform(next(ks), (N_EVEN, N_DIR, W), f32, 0.9, 0.999)
    a = a_c ** (1.0 / LRU_C)
    lru_lambda = jnp.log(a) - jnp.log1p(-a)
    lru_w_r = nrm((N_EVEN, N_DIR, LRU_HEADS, LRU_HEAD_DIM, LRU_HEAD_DIM), LRU_HEAD_DIM ** -0.5)
    lru_b_r = nrm((N_EVEN, N_DIR, W), 0.01)
    lru_w_i = nrm((N_EVEN, N_DIR, LRU_HEADS, LRU_HEAD_DIM, LRU_HEAD_DIM), LRU_HEAD_DIM ** -0.5)
    lru_b_i = nrm((N_EVEN, N_DIR, W), 0.01)
    expo = 5.0 + jnp.arange(RET_HEADS, dtype=f32)
    ret_decay = jnp.log(2.0 ** expo - 1.0) + nrm((N_EVEN, N_DIR, RET_HEADS), 0.1)
    ret_norm_g = 1.0 + nrm((N_EVEN, W), 0.02)
    sconv_w = nrm((N_ODD, SCONV, W), SCONV ** -0.5)
    final_norm_g = 1.0 + nrm((D,), 0.02)
    return {'x_prompt': x_prompt, 'x_sample': x_sample, 'state_lru': state_lru, 'state_ret': state_ret,
            'c': c, 'c_ctx': c_ctx, 'norm_g': norm_g, 'ada_w': ada_w, 'ada_b': ada_b,
            'w_in': w_in, 'w_out': w_out, 'lru_conv_w': lru_conv_w, 'lru_conv_b': lru_conv_b,
            'lru_lambda': lru_lambda, 'lru_w_r': lru_w_r, 'lru_b_r': lru_b_r, 'lru_w_i': lru_w_i,
            'lru_b_i': lru_b_i, 'ret_decay': ret_decay, 'ret_norm_g': ret_norm_g,
            'sconv_w': sconv_w, 'final_norm_g': final_norm_g}


def reference(x_prompt, x_sample, state_lru, state_ret, c, c_ctx, norm_g, ada_w, ada_b, w_in, w_out,
              lru_conv_w, lru_conv_b, lru_lambda, lru_w_r, lru_b_r, lru_w_i, lru_b_i,
              ret_decay, ret_norm_g, sconv_w, final_norm_g):
    rope = grid_rope(x_sample.shape[1])
    cond_ctx = c_ctx[None, :]
    b_ctx = x_prompt.shape[0]
    zero_lru = jnp.zeros((b_ctx, N_DIR, BRANCH), jnp.float32)
    zero_ret = jnp.zeros((b_ctx, N_DIR, RET_HEADS, RET_HEAD_DIM, RET_HEAD_DIM), jnp.float32)
    xp, xs = x_prompt, x_sample
    lru_states, ret_states = [], []
    for l in range(DEPTH):
        j = l // 2
        shared = (norm_g[l], ada_w[l], ada_b[l], w_in[l], w_out[l])
        if l % 2 == 0:
            mix = (lru_conv_w[j], lru_conv_b[j], lru_lambda[j], lru_w_r[j], lru_b_r[j],
                   lru_w_i[j], lru_b_i[j], ret_decay[j], ret_norm_g[j])
            xp, s_lru, s_ret = layer_lru_retention(xp, cond_ctx, zero_lru, zero_ret, None, *shared, *mix)
            xs, _, _ = layer_lru_retention(xs, c, state_lru[:, j], state_ret[:, j], rope, *shared, *mix)
            lru_states.append(s_lru)
            ret_states.append(s_ret)
        else:
            xp = layer_fourier_shortconv(xp, cond_ctx, *shared, sconv_w[j])
            xs = layer_fourier_shortconv(xs, c, *shared, sconv_w[j])
    y_prompt = rmsnorm(xp, final_norm_g)
    y_sample = rmsnorm(xs, final_norm_g)
    new_state_lru = jnp.stack(lru_states, axis=1).astype(x_prompt.dtype)
    new_state_ret = jnp.stack(ret_states, axis=1).astype(x_prompt.dtype)
    return (y_prompt, y_sample, new_state_lru, new_state_ret)
```

```cpp
#include <hip/hip_runtime.h>
#include <hip/hip_cooperative_groups.h>
#include <cstdio>
namespace cg = cooperative_groups;

#ifndef MK_PER_PHASE_LAUNCH
#define MK_PER_PHASE_LAUNCH 1
#endif

#define LAS __attribute__((address_space(3)))
typedef unsigned short bf16_t;
typedef short bf16x8 __attribute__((ext_vector_type(8)));
typedef float f32x4 __attribute__((ext_vector_type(4)));
typedef float f32x2 __attribute__((ext_vector_type(2)));
typedef unsigned u32x4 __attribute__((ext_vector_type(4)));
typedef unsigned u32x2 __attribute__((ext_vector_type(2)));

constexpr int D = 2048, WB = 1024, NTOK = 24576, NPR = 8192;
constexpr int LDS_BYTES = 147456;
constexpr float EPSV = 1e-6f;
constexpr float LOG2E = 1.4426950408889634f;
constexpr size_t SLICE_ELEMS = (size_t)NTOK * WB;

constexpr size_t WS_CTL = 0;
constexpr size_t WS_MOD = 65536;
constexpr size_t WS_WG = WS_MOD + 524288;
constexpr size_t WS_ROPE = WS_WG + (1u << 20);
constexpr size_t WS_TAB1 = WS_ROPE + (1u << 20);
constexpr size_t WS_TAB2P = WS_TAB1 + (256u << 10);
constexpr size_t WS_TAB2S = WS_TAB2P + (256u << 10);
constexpr size_t WS_CARR = WS_TAB2S + (16u << 20);
constexpr size_t WS_WIN = WS_CARR + (6u << 20);
constexpr size_t WS_WOUT = WS_WIN + (48u << 20);
constexpr size_t WS_P = WS_WOUT + (16u << 20);
constexpr size_t WS_H = WS_P + (288ull << 20);
constexpr size_t WS_END = WS_H + (96ull << 20);
constexpr size_t OUT_SLRU = (size_t)NTOK * D;
constexpr size_t OUT_SRET = OUT_SLRU + 65536;

struct Params {
    const float *x_prompt, *x_sample, *state_lru, *state_ret, *c, *c_ctx, *norm_g, *ada_w, *ada_b, *w_in, *w_out,
        *lru_conv_w, *lru_conv_b, *lru_lambda, *lru_w_r, *lru_b_r, *lru_w_i, *lru_b_i, *ret_decay, *ret_norm_g, *sconv_w, *final_norm_g;
    float* out; unsigned char* ws; int ph_lo, ph_hi;
};

__device__ __forceinline__ unsigned pk2(float lo, float hi) { unsigned r; asm("v_cvt_pk_bf16_f32 %0, %1, %2" : "=v"(r) : "v"(lo), "v"(hi)); return r; }
__device__ __forceinline__ bf16_t f2bf(float f) { return (bf16_t)(pk2(f, 0.f) & 0xffffu); }
__device__ __forceinline__ float bflo(unsigned u) { return __uint_as_float(u << 16); }
__device__ __forceinline__ float bfhi(unsigned u) { return __uint_as_float(u & 0xffff0000u); }
__device__ __forceinline__ float sigm(float x) { return __builtin_amdgcn_rcpf(1.f + __expf(-x)); }
__device__ __forceinline__ float silu(float x) { return x * sigm(x); }
__device__ __forceinline__ float wave_sum(float v) {
#pragma unroll
    for (int o = 1; o < 64; o <<= 1) v += __shfl_xor(v, o);
    return v;
}
#define LDS_FENCE() asm volatile("s_waitcnt lgkmcnt(0)" ::: "memory")

namespace pg8 {
constexpr int BM = 256, BK = 64, HALF = 128, HTB = HALF * BK * 2, STAGE_BYTES = 8 * HTB;
__device__ __forceinline__ int lds_byte(int r, int c) { const int st = (r >> 4) * 2 + (c >> 5), rr = r & 15, cc = c & 31, ob = rr * 64 + cc * 2; return st * 1024 + (ob ^ (((ob >> 9) & 1) << 5)); }
__device__ __forceinline__ void stage_rc(int b, int& R, int& C) { const int st = b / 1024, sb = b % 1024, swz = sb ^ (((sb >> 9) & 1) << 5); R = (st >> 1) * 16 + swz / 64; C = (st & 1) * 32 + (swz % 64) / 2; }
__device__ __forceinline__ int perm32(int rho) { const int n = rho >> 4, i = rho & 15; return 8 * (i >> 2) + 4 * n + (i & 3); }

struct GUnit { const char* A; const char* B; long coff; int aux, aux2; };
struct GCfg { int lda, ldb, nt, ksplit; long ksoff; };

template <class Epi, class Sched>
__device__ __forceinline__ void gemm_phase(LAS unsigned char* lds, const GCfg g, const Sched& S, const Epi& E) {
    const int tid = threadIdx.x, wid = __builtin_amdgcn_readfirstlane(tid >> 6), lane = tid & 63, wr = wid >> 2, wc = wid & 3, fr = lane & 15, fq = lane >> 4;
    const int nt = g.nt;
    unsigned voffA[2], voffB[2];
#pragma unroll
    for (int i = 0; i < 2; ++i) { int R, C; stage_rc(tid * 16 + i * 8192, R, C); const int Rb = Epi::PERM ? ((R & ~31) + perm32(R & 31)) : R;
        voffA[i] = (unsigned)(R * g.lda + C) * 2u; voffB[i] = (unsigned)(Rb * g.ldb + C) * 2u; }
    const size_t kstep = (size_t)(BK * 2);
    const size_t hstepA = (size_t)HALF * g.lda * 2, hstepB = (size_t)HALF * g.ldb * 2;
    const unsigned ldsw = (unsigned)wid * 1024u;
    const int aoff = lds_byte(wr * 64 + fr, fq * 8), boff = lds_byte(wc * 32 + fr, fq * 8);
#define PG8_AKT(base, t) ((base) + (size_t)(t) * kstep + ((t) >= g.ksplit ? g.ksoff : 0l))
#define PG8_SA(b, h) (((b) * 2 + (h)) * HTB)
#define PG8_SB(b, h) ((4 + (b) * 2 + (h)) * HTB)
#define PG8_STAGE(bufoff, gbase, voff) do { _Pragma("unroll") for (int _i = 0; _i < 2; ++_i) \
        __builtin_amdgcn_global_load_lds((const unsigned*)((const char*)(gbase) + (voff)[_i]), (LAS unsigned*)(lds + (bufoff) + ldsw + _i * 8192), 16, 0, 0); } while (0)
#define PG8_LDA(dst, b, h) do { _Pragma("unroll") for (int m = 0; m < 4; ++m) _Pragma("unroll") for (int k = 0; k < 2; ++k) dst[m][k] = *(const LAS bf16x8*)(lds + PG8_SA(b, h) + aoff + m * 2048 + k * 1024); } while (0)
#define PG8_LDB(dst, b, h) do { _Pragma("unroll") for (int n = 0; n < 2; ++n) _Pragma("unroll") for (int k = 0; k < 2; ++k) dst[n][k] = *(const LAS bf16x8*)(lds + PG8_SB(b, h) + boff + n * 2048 + k * 1024); } while (0)
#define PG8_MMA(ai, bj, At, Bt) do { __builtin_amdgcn_s_setprio(1); _Pragma("unroll") for (int m = 0; m < 4; ++m) _Pragma("unroll") for (int n = 0; n < 2; ++n) _Pragma("unroll") for (int k = 0; k < 2; ++k) \
        acc[ai][bj][m][n] = __builtin_amdgcn_mfma_f32_16x16x32_bf16(Bt[n][k], At[m][k], acc[ai][bj][m][n], 0, 0, 0); __builtin_amdgcn_s_setprio(0); } while (0)
#define PG8_WAIT_V(n) asm volatile("s_waitcnt vmcnt(" #n ")" ::: "memory")
#define PG8_WAIT_L(n) asm volatile("s_waitcnt lgkmcnt(" #n ")" ::: "memory")
#define PG8_BAR __builtin_amdgcn_s_barrier()
#define PG8_SCHED __builtin_amdgcn_sched_barrier(0)
    GUnit cur, nxt; int ui = 0;
    if (!S.next(0, cur)) return;
    f32x4 acc[2][2][4][2];
#pragma unroll
    for (int a = 0; a < 2; ++a)
#pragma unroll
        for (int b = 0; b < 2; ++b)
#pragma unroll
            for (int m = 0; m < 4; ++m)
#pragma unroll
                for (int n = 0; n < 2; ++n) acc[a][b][m][n] = (f32x4){0.f, 0.f, 0.f, 0.f};
    bf16x8 At[4][2], B0[2][2], B1[2][2];
    const char* cA = cur.A; const char* cB = cur.B;
    PG8_STAGE(PG8_SB(0, 0), cB, voffB); PG8_STAGE(PG8_SA(0, 0), cA, voffA); PG8_STAGE(PG8_SB(0, 1), cB + hstepB, voffB); PG8_STAGE(PG8_SA(0, 1), cA + hstepA, voffA);
    if (wr == 1) PG8_BAR;
    PG8_WAIT_V(4); PG8_BAR;
    PG8_STAGE(PG8_SB(1, 0), cB + kstep, voffB); PG8_STAGE(PG8_SA(1, 0), cA + kstep, voffA); PG8_STAGE(PG8_SB(1, 1), cB + hstepB + kstep, voffB);
    PG8_WAIT_V(6); PG8_BAR;
    for (;;) {
        const bool has_next = S.next(ui + 1, nxt);
        const char* nA = has_next ? nxt.A : cA; const char* nB = has_next ? nxt.B : cB;
        for (int t = 0; t < nt; t += 2) {
            const bool last = (t == nt - 2);
            const char* a1 = PG8_AKT(cA, t + 1);
            const char* a2 = last ? nA : PG8_AKT(cA, t + 2); const char* b2 = last ? nB : cB + (size_t)(t + 2) * kstep;
            const char* a3 = a2 + kstep; const char* b3 = b2 + kstep;
            PG8_LDB(B0, 0, 0); PG8_SCHED; PG8_LDA(At, 0, 0); PG8_STAGE(PG8_SA(1, 1), a1 + hstepA, voffA);
            PG8_WAIT_L(8); PG8_BAR; PG8_WAIT_L(0); PG8_MMA(0, 0, At, B0); PG8_BAR; PG8_SCHED;
            PG8_LDB(B1, 0, 1); PG8_STAGE(PG8_SB(0, 0), b2, voffB);
            PG8_BAR; PG8_WAIT_L(0); PG8_MMA(0, 1, At, B1); PG8_BAR;
            PG8_LDA(At, 0, 1); PG8_STAGE(PG8_SA(0, 0), a2, voffA);
            PG8_BAR; PG8_WAIT_L(0); PG8_MMA(1, 0, At, B0); PG8_BAR; PG8_SCHED;
            PG8_STAGE(PG8_SB(0, 1), b2 + hstepB, voffB);
            PG8_WAIT_V(6); PG8_BAR; PG8_MMA(1, 1, At, B1); PG8_BAR;
            PG8_LDB(B0, 1, 0); PG8_SCHED; PG8_LDA(At, 1, 0); PG8_STAGE(PG8_SA(0, 1), a2 + hstepA, voffA);
            PG8_WAIT_L(8); PG8_BAR; PG8_WAIT_L(0); PG8_MMA(0, 0, At, B0); PG8_BAR; PG8_SCHED;
            PG8_LDB(B1, 1, 1); PG8_STAGE(PG8_SB(1, 0), b3, voffB);
            PG8_BAR; PG8_WAIT_L(0); PG8_MMA(0, 1, At, B1); PG8_BAR;
            PG8_LDA(At, 1, 1); PG8_STAGE(PG8_SA(1, 0), a3, voffA);
            PG8_BAR; PG8_WAIT_L(0); PG8_MMA(1, 0, At, B0); PG8_BAR; PG8_SCHED;
            PG8_STAGE(PG8_SB(1, 1), b3 + hstepB, voffB);
            PG8_WAIT_V(6); PG8_BAR; PG8_MMA(1, 1, At, B1); PG8_BAR;
        }
        E(acc, cur, wr, wc, fr, fq);
        if (!has_next) break;
#pragma unroll
        for (int a = 0; a < 2; ++a)
#pragma unroll
            for (int b = 0; b < 2; ++b)
#pragma unroll
                for (int m = 0; m < 4; ++m)
#pragma unroll
                    for (int n = 0; n < 2; ++n) acc[a][b][m][n] = (f32x4){0.f, 0.f, 0.f, 0.f};
        cur = nxt; cA = nA; cB = nB; ++ui;
    }
    PG8_WAIT_V(0);
    if (wr == 0) PG8_BAR;
    PG8_BAR;
#undef PG8_AKT
#undef PG8_SA
#undef PG8_SB
#undef PG8_STAGE
#undef PG8_LDA
#undef PG8_LDB
#undef PG8_MMA
#undef PG8_WAIT_V
#undef PG8_WAIT_L
#undef PG8_BAR
#undef PG8_SCHED
}

__device__ __forceinline__ bool mn_order(int i, int G, int c, int nM, int nN, int& pm, int& pn) {
    const int nwg = nM * nN; const long L = (long)i * G + c; if (L >= nwg) return false;
    int wgid = (int)L; { const int q = nwg / 8, r = nwg % 8, xcd = wgid % 8, off = wgid / 8; wgid = (xcd < r ? xcd * (q + 1) : r * (q + 1) + (xcd - r) * q) + off; }
    const int nig = 8 * nN, gid = wgid / nig, fm = gid * 8, gsz = (nM - fm) < 8 ? (nM - fm) : 8;
    pm = fm + ((wgid % nig) % gsz); pn = (wgid % nig) / gsz; return true;
}
struct SchedInProj {
    const char* A; const char* B; int G, c;
    __device__ __forceinline__ bool next(int i, GUnit& u) const { int pm, pn; if (!mn_order(i, G, c, NTOK / 256, 24, pm, pn)) return false;
        u.A = A + (size_t)pm * 256 * 2048 * 2; u.B = B + (size_t)pn * 256 * 2048 * 2; u.coff = (long)((size_t)(pn >> 2) * SLICE_ELEMS + (size_t)pm * 256 * 1024 + (pn & 3) * 256); u.aux = 0; u.aux2 = 0; return true; }
};
struct SchedOutProj {
    const char* A; const char* B; int G, c;
    __device__ __forceinline__ bool next(int i, GUnit& u) const { int pm, pn; if (!mn_order(i, G, c, NTOK / 256, 8, pm, pn)) return false;
        u.A = A + (size_t)pm * 256 * 1024 * 2; u.B = B + (size_t)pn * 256 * 2048 * 2; u.coff = (long)((size_t)pm * 256 * 2048 + pn * 256);
        const int r0 = pm * 256; u.aux = r0 < NPR ? 8 : ((r0 - NPR) >> 11); u.aux2 = r0 >= NPR; return true; }
};
struct SchedF1 {
    const char* Tab1; const char* X0  ; int G, c, T, nb; long pqt0;
    __device__ __forceinline__ bool next(int i, GUnit& u) const { const int ntn = T >> 8; const long L = (long)i * G + c; if (L >= (long)nb * 8 * ntn) return false;
        const int tn = (int)(L % ntn), pm = (int)((L / ntn) & 1), gq = (int)((L / (2 * ntn)) & 3), b = (int)(L / (8 * ntn));
        u.A = Tab1 + (size_t)pm * 256 * 256 * 2; u.B = X0 + ((size_t)(b * T + tn * 256) * 1024 + gq * 256) * 2;
        u.coff = pqt0 + (long)(b * 1024 + gq * 256) * (2 * T) + (long)pm * T + tn * 256; u.aux = 0; u.aux2 = 0; return true; }
};
struct SchedF2 {
    const char* Tab2; const char* PQT0; int G, c, T, nb, rowbase;
    __device__ __forceinline__ bool next(int i, GUnit& u) const { const int nm = T >> 8; const long L = (long)i * G + c; if (L >= (long)nb * 4 * nm) return false;
        const int pm = (int)(L % nm), pn = (int)((L / nm) & 3), b = (int)(L / (4 * nm));
        u.A = Tab2 + (size_t)pm * 256 * (2 * T) * 2; u.B = PQT0 + ((size_t)(b * 1024 + pn * 256) * (2 * T)) * 2;
        u.coff = (long)(SLICE_ELEMS + (size_t)(rowbase + b * T + pm * 256) * 1024 + pn * 256); u.aux = 0; u.aux2 = 0; return true; }
};

struct EpiBf16Store {
    static constexpr bool PERM = true;
    bf16_t* O; int ldc;
    __device__ __forceinline__ void operator()(const f32x4 (&acc)[2][2][4][2], const GUnit& u, int wr, int wc, int fr, int fq) const {
        bf16_t* base = O + u.coff + (size_t)(wr * 64 + fr) * ldc + wc * 32 + 8 * fq;
#pragma unroll
        for (int ai = 0; ai < 2; ++ai)
#pragma unroll
            for (int m = 0; m < 4; ++m) { bf16_t* rowp = base + (size_t)(ai * HALF + m * 16) * ldc;
#pragma unroll
                for (int bj = 0; bj < 2; ++bj) { const f32x4 v0 = acc[ai][bj][m][0], v1 = acc[ai][bj][m][1];
                    u32x4 w; w.x = pk2(v0[0], v0[1]); w.y = pk2(v0[2], v0[3]); w.z = pk2(v1[0], v1[1]); w.w = pk2(v1[2], v1[3]);
                    *(u32x4*)(rowp + bj * HALF) = w; } }
    }
};
struct EpiSiluInPlace {
    static constexpr bool PERM = true;
    bf16_t* O;
    __device__ __forceinline__ void operator()(const f32x4 (&acc)[2][2][4][2], const GUnit& u, int wr, int wc, int fr, int fq) const {
        bf16_t* base = O + u.coff + (size_t)(wr * 64 + fr) * 1024 + wc * 32 + 8 * fq;
#pragma unroll
        for (int ai = 0; ai < 2; ++ai)
#pragma unroll
            for (int m = 0; m < 4; ++m) { bf16_t* rowp = base + (size_t)(ai * HALF + m * 16) * 1024;
#pragma unroll
                for (int bj = 0; bj < 2; ++bj) { const f32x4 v0 = acc[ai][bj][m][0], v1 = acc[ai][bj][m][1];
                    const u32x4 gv = *(const u32x4*)(rowp + bj * HALF);
                    u32x4 w; w.x = pk2(v0[0] * silu(bflo(gv.x)), v0[1] * silu(bfhi(gv.x))); w.y = pk2(v0[2] * silu(bflo(gv.y)), v0[3] * silu(bfhi(gv.y)));
                    w.z = pk2(v1[0] * silu(bflo(gv.z)), v1[1] * silu(bfhi(gv.z))); w.w = pk2(v1[2] * silu(bflo(gv.w)), v1[3] * silu(bfhi(gv.w)));
                    *(u32x4*)(rowp + bj * HALF) = w; } }
    }
};
struct EpiResid {
    static constexpr bool PERM = false;
    const float* xin0; const float* xin1; float* out; const float* gate;
    __device__ __forceinline__ void operator()(const f32x4 (&acc)[2][2][4][2], const GUnit& u, int wr, int wc, int fr, int fq) const {
        const size_t off0 = (size_t)u.coff + (size_t)(wr * 64 + fr) * 2048 + wc * 32 + 4 * fq;
        const int col0 = (int)(u.coff & 2047) + wc * 32 + 4 * fq;
        const float* xb = u.aux2 ? xin1 : xin0; const float* gp = gate + (size_t)u.aux * 6144 + col0;
        f32x4 gv[2][2];
#pragma unroll
        for (int bj = 0; bj < 2; ++bj)
#pragma unroll
            for (int n = 0; n < 2; ++n) gv[bj][n] = *(const f32x4*)(gp + bj * HALF + n * 16);
#pragma unroll
        for (int ai = 0; ai < 2; ++ai)
#pragma unroll
            for (int m = 0; m < 4; ++m) { const size_t off = off0 + (size_t)(ai * HALF + m * 16) * 2048;
#pragma unroll
                for (int bj = 0; bj < 2; ++bj)
#pragma unroll
                    for (int n = 0; n < 2; ++n) { const f32x4 xv = *(const f32x4*)(xb + off + bj * HALF + n * 16);
                        *(f32x4*)(out + off + bj * HALF + n * 16) = xv + gv[bj][n] * acc[ai][bj][m][n]; } }
    }
};
}

__device__ __forceinline__ void mod_unit(const Params& p, LAS unsigned char* lds, int u) {
    const int tid = threadIdx.x, lane = tid & 63, wave = tid >> 6;
    LAS float* scond = (LAS float*)lds;
    for (int i = tid; i < 9 * 2048; i += 512) { const int ci = i >> 11, k = i & 2047; const float v = ci < 8 ? p.c[ci * 2048 + k] : p.c_ctx[k]; scond[i] = silu(v); }
    __syncthreads();
    const int l = u / 48, n0 = (u % 48) * 128, ct = lane & 31, rg = 2 * wave + (lane >> 5);
    const float* Wp = p.ada_w + (size_t)l * 2048 * 6144 + n0 + ct * 4;
    float acc[9][4];
#pragma unroll
    for (int ci = 0; ci < 9; ++ci)
#pragma unroll
        for (int j = 0; j < 4; ++j) acc[ci][j] = 0.f;
#pragma unroll 8
    for (int k = rg; k < 2048; k += 16) {
        const f32x4 w = *(const f32x4*)(Wp + (size_t)k * 6144);
#pragma unroll
        for (int ci = 0; ci < 9; ++ci) { const float s = scond[ci * 2048 + k]; acc[ci][0] += s * w[0]; acc[ci][1] += s * w[1]; acc[ci][2] += s * w[2]; acc[ci][3] += s * w[3]; }
    }
#pragma unroll
    for (int ci = 0; ci < 9; ++ci)
#pragma unroll
        for (int j = 0; j < 4; ++j) acc[ci][j] += __shfl_xor(acc[ci][j], 32);
    __syncthreads();
    LAS float* red = (LAS float*)lds;
    if (lane < 32) {
#pragma unroll
        for (int ci = 0; ci < 9; ++ci)
#pragma unroll
            for (int j = 0; j < 4; ++j) red[(wave * 32 + ct) * 36 + ci * 4 + j] = acc[ci][j];
    }
    __syncthreads();
    float* mod = (float*)(p.ws + WS_MOD);
    for (int o = tid; o < 9 * 128; o += 512) { const int ci = o >> 7, col = o & 127, ct2 = col >> 2, j = col & 3; float s = 0.f;
#pragma unroll
        for (int w = 0; w < 8; ++w) s += red[(w * 32 + ct2) * 36 + ci * 4 + j];
        mod[(size_t)(l * 9 + ci) * 6144 + n0 + col] = s + p.ada_b[l * 6144 + n0 + col]; }
    __syncthreads();
}
__device__ __forceinline__ void transpose_item(const float* Wm, int K, int N, bf16_t* WT, LAS float* scr, int item, int lane) {
    const int nblk = N / 64, kb = item / nblk, nb = item % nblk, k0 = 64 * kb, n0 = 64 * nb;
#pragma unroll 8
    for (int i = 0; i < 64; ++i) scr[i * 65 + lane] = Wm[(size_t)(k0 + i) * N + n0 + lane];
    LDS_FENCE();
    const int cc = lane & 7;
#pragma unroll
    for (int j = 0; j < 8; ++j) { const int n = (lane >> 3) + 8 * j; const LAS float* s = scr + (8 * cc) * 65 + n;
        u32x4 o; o.x = pk2(s[0 * 65], s[1 * 65]); o.y = pk2(s[2 * 65], s[3 * 65]); o.z = pk2(s[4 * 65], s[5 * 65]); o.w = pk2(s[6 * 65], s[7 * 65]);
        *(u32x4*)(WT + (size_t)(n0 + n) * K + k0 + 8 * cc) = o; }
    LDS_FENCE();
}
__device__ __forceinline__ void ph0_prep(const Params& p, LAS unsigned char* lds) {
    const int tid = threadIdx.x, lane = tid & 63, wave = tid >> 6, G = gridDim.x, bid = blockIdx.x;
    for (int u = bid; u < 96; u += G) mod_unit(p, lds, u);
    { LAS float* scr = (LAS float*)(lds + wave * 16640);
      const int gw = bid * 8 + wave, NGW = G * 8;
      bf16_t* WinT = (bf16_t*)(p.ws + WS_WIN); bf16_t* WoutT = (bf16_t*)(p.ws + WS_WOUT);
      constexpr int I_IN = 32 * 96, I_OUT = 32 * 32;
      for (int it = gw; it < 2 * I_IN + 2 * I_OUT; it += NGW) {
          int r = it;
          if (r < 2 * I_IN) { const int l = r / I_IN; r -= l * I_IN; transpose_item(p.w_in + (size_t)l * 2048 * 6144, 2048, 6144, WinT + (size_t)l * 6144 * 2048, scr, r, lane); }
          else { r -= 2 * I_IN; const int l = r / I_OUT; r -= l * I_OUT; transpose_item(p.w_out + (size_t)l * 2048 * 2048, 2048, 2048, WoutT + (size_t)l * 2048 * 2048, scr, r, lane); }
      } }
    const int gt = bid * 512 + tid, NT = G * 512;
    { bf16_t* Wg = (bf16_t*)(p.ws + WS_WG);
      for (int idx = gt; idx < 8 * 512 * 128; idx += NT) { const int i = idx & 127, n = (idx >> 7) & 511, h = idx >> 16, g = n >> 7, j = n & 127;
          const float* src = (g & 1) ? p.lru_w_i : p.lru_w_r; const int dir = g >> 1;
          Wg[idx] = f2bf(src[((size_t)(dir * 8 + h) * 128 + i) * 128 + j]); } }
    { float* rc = (float*)(p.ws + WS_ROPE); float* rs = rc + 2048 * 64;
      for (int idx = gt; idx < 2048 * 64; idx += NT) { const int f = idx & 63, t = idx >> 6; const float pos = (f < 32) ? (float)(t >> 6) : (float)(t & 63);
          const float fr = powf(10000.0f, -(float)(f & 31) / 32.0f); const float ang = pos * fr; rc[idx] = cosf(ang); rs[idx] = sinf(ang); } }
    { bf16_t* T1 = (bf16_t*)(p.ws + WS_TAB1);
      for (int i8 = gt; i8 < 512 * 256 / 8; i8 += NT) { const int j = (i8 * 8) >> 8, c0 = (i8 * 8) & 255; float v[8];
#pragma unroll
          for (int e = 0; e < 8; ++e) { const int m = ((j & 255) * (c0 + e)) & 255; const float a = (float)m * (2.0f / 256.0f); v[e] = (j < 256 ? cospif(a) : sinpif(a)) * 0.0625f; }
          u32x4 o; o.x = pk2(v[0], v[1]); o.y = pk2(v[2], v[3]); o.z = pk2(v[4], v[5]); o.w = pk2(v[6], v[7]); *(u32x4*)(T1 + (size_t)i8 * 8) = o; } }
#pragma unroll
    for (int which = 0; which < 2; ++which) {
        const int T = which ? 2048 : 256; const int sh = which ? 12 : 9;
        bf16_t* T2 = (bf16_t*)(p.ws + (which ? WS_TAB2S : WS_TAB2P)); const float sc = which ? 0.02209708691207961f : 0.0625f;
        for (int i8 = gt; i8 < T * 2 * T / 8; i8 += NT) { const int k1 = (i8 * 8) >> sh, c0 = (i8 * 8) & (2 * T - 1); float v[8];
#pragma unroll
            for (int e = 0; e < 8; ++e) { const int col = c0 + e, t = col & (T - 1); const int m = (k1 * t) & (T - 1); const float a = (float)m * (2.0f / (float)T);
                v[e] = (col < T ? cospif(a) : -sinpif(a)) * sc; }
            u32x4 o; o.x = pk2(v[0], v[1]); o.y = pk2(v[2], v[3]); o.z = pk2(v[4], v[5]); o.w = pk2(v[6], v[7]); *(u32x4*)(T2 + (size_t)i8 * 8) = o; }
    }
}

__device__ __forceinline__ void normmod_phase(const Params& p, const float* x0, const float* x1  , int l) {
    const int tid = threadIdx.x, lane = tid & 63, wave = tid >> 6;
    const float* mod = (const float*)(p.ws + WS_MOD) + (size_t)l * 9 * 6144; const float* ng = p.norm_g + l * 2048;
    bf16_t* H = (bf16_t*)(p.ws + WS_H);
    for (int row = blockIdx.x * 8 + wave; row < NTOK; row += gridDim.x * 8) {
        const float* xr = (row < NPR ? x0 : x1) + (size_t)row * D; const int ci = row < NPR ? 8 : ((row - NPR) >> 11);
        f32x4 v[8]; float ss = 0.f;
#pragma unroll
        for (int j = 0; j < 8; ++j) { v[j] = *(const f32x4*)(xr + 4 * lane + 256 * j); ss += (v[j][0] * v[j][0] + v[j][1] * v[j][1]) + (v[j][2] * v[j][2] + v[j][3] * v[j][3]); }
        const float rstd = 1.0f / sqrtf(wave_sum(ss) * (1.0f / 2048.0f) + EPSV);
        const float* sh = mod + (size_t)ci * 6144; const float* sc = sh + 2048;
#pragma unroll
        for (int j = 0; j < 8; ++j) { const int col = 4 * lane + 256 * j; const f32x4 g = *(const f32x4*)(ng + col), s1 = *(const f32x4*)(sc + col), s0 = *(const f32x4*)(sh + col);
            const f32x4 hv = (v[j] * rstd * g) * (1.0f + s1) + s0;
            u32x2 o; o.x = pk2(hv[0], hv[1]); o.y = pk2(hv[2], hv[3]); *(u32x2*)(H + (size_t)row * D + col) = o; }
    }
}

__device__ __forceinline__ int ret_slot(int seq, int h, int dir, int ch) { return seq < 32 ? (((seq * 8 + h) * 2 + dir) * 2 + ch) : (1024 + ((((seq - 32) * 8 + h) * 2 + dir) * 16 + ch)); }
__device__ __forceinline__ void ret_chain(const Params& p, LAS unsigned char* lds, int seq, int h, int dir, int eh) {
    const int tid = threadIdx.x, lane = tid & 63, w = tid >> 6, q = lane >> 4, fr = lane & 15;
    LAS unsigned char* Kt = lds;
    LAS unsigned char* Vt = lds + 34816;
    const bool smp = seq >= 32; const int nch = smp ? 16 : 2; const int rb = smp ? NPR + (seq - 32) * 2048 : seq * 256;
    const bf16_t* Pk = (const bf16_t*)(p.ws + WS_P) + 3 * SLICE_ELEMS; const bf16_t* Pv = (const bf16_t*)(p.ws + WS_P) + 4 * SLICE_ELEMS;
    bf16_t* Sbuf = (bf16_t*)(p.ws + WS_H);
    const float* ropeC = (const float*)(p.ws + WS_ROPE); const float* ropeS = ropeC + 2048 * 64;
    const float lg2 = -log1pf(expf(-p.ret_decay[dir * 8 + h])) * LOG2E;
    const float cd = exp2f(lg2 * 128.0f);
    f32x4 acc[4];
    if (smp) { const float* S0 = p.state_ret + (size_t)(((seq - 32) * 2 + dir) * 8 + h) * 16384;
#pragma unroll
        for (int nb = 0; nb < 4; ++nb)
#pragma unroll
            for (int r = 0; r < 4; ++r) acc[nb][r] = S0[(16 * w + 4 * q + r) * 128 + 64 * eh + 16 * nb + fr]; }
    else {
#pragma unroll
        for (int nb = 0; nb < 4; ++nb) acc[nb] = (f32x4){0.f, 0.f, 0.f, 0.f}; }
    for (int step = 0; step < nch; ++step) {
        const int ch = dir ? nch - 1 - step : step;
        { bf16_t* Sd = Sbuf + (size_t)ret_slot(seq, h, dir, ch) * 16384;
#pragma unroll
          for (int nb = 0; nb < 4; ++nb) { u32x2 v; v.x = pk2(acc[nb][0], acc[nb][1]); v.y = pk2(acc[nb][2], acc[nb][3]);
              *(u32x2*)(Sd + (64 * eh + 16 * nb + fr) * 128 + 16 * w + 4 * q) = v; } }
        { const int tp = tid & 63, fg = tid >> 6, f0 = fg * 8; float o1[2][8], o2[2][8];
#pragma unroll
          for (int tk = 0; tk < 2; ++tk) { const int tl = 2 * tp + tk; const size_t row = (size_t)(rb + ch * 128 + tl);
              const u32x4 a = *(const u32x4*)(Pk + row * 1024 + h * 128 + f0), b = *(const u32x4*)(Pk + row * 1024 + h * 128 + 64 + f0);
              const float x1[8] = {bflo(a.x), bfhi(a.x), bflo(a.y), bfhi(a.y), bflo(a.z), bfhi(a.z), bflo(a.w), bfhi(a.w)};
              const float x2[8] = {bflo(b.x), bfhi(b.x), bflo(b.y), bfhi(b.y), bflo(b.z), bfhi(b.z), bflo(b.w), bfhi(b.w)};
              const float dec = exp2f(lg2 * (float)(dir ? tl : 127 - tl)) * 0.08838834764831845f;
              if (smp) { const int t = ch * 128 + tl; const f32x4 c0 = *(const f32x4*)(ropeC + t * 64 + f0), c1 = *(const f32x4*)(ropeC + t * 64 + f0 + 4), s0 = *(const f32x4*)(ropeS + t * 64 + f0), s1 = *(const f32x4*)(ropeS + t * 64 + f0 + 4);
#pragma unroll
                  for (int j = 0; j < 8; ++j) { const float cs = j < 4 ? c0[j & 3] : c1[j & 3], sn = j < 4 ? s0[j & 3] : s1[j & 3]; o1[tk][j] = (x1[j] * cs - x2[j] * sn) * dec; o2[tk][j] = (x1[j] * sn + x2[j] * cs) * dec; } }
              else {
#pragma unroll
                  for (int j = 0; j < 8; ++j) { o1[tk][j] = x1[j] * dec; o2[tk][j] = x2[j] * dec; } } }
#pragma unroll
          for (int j = 0; j < 8; ++j) { *(LAS unsigned*)(Kt + (f0 + j) * 272 + tp * 4) = pk2(o1[0][j], o1[1][j]); *(LAS unsigned*)(Kt + (64 + f0 + j) * 272 + tp * 4) = pk2(o2[0][j], o2[1][j]); }
          const size_t row0 = (size_t)(rb + ch * 128 + 2 * tp);
          const u32x4 va = *(const u32x4*)(Pv + row0 * 1024 + h * 128 + 64 * eh + f0), vb = *(const u32x4*)(Pv + (row0 + 1) * 1024 + h * 128 + 64 * eh + f0);
          const unsigned wa[4] = {va.x, va.y, va.z, va.w}, wb[4] = {vb.x, vb.y, vb.z, vb.w};
#pragma unroll
          for (int j = 0; j < 4; ++j) { *(LAS unsigned*)(Vt + (f0 + 2 * j) * 272 + tp * 4) = (wa[j] & 0xffffu) | (wb[j] << 16); *(LAS unsigned*)(Vt + (f0 + 2 * j + 1) * 272 + tp * 4) = (wa[j] >> 16) | (wb[j] & 0xffff0000u); } }
        __syncthreads();
#pragma unroll
        for (int nb = 0; nb < 4; ++nb) acc[nb] = acc[nb] * cd;
#pragma unroll
        for (int ks = 0; ks < 4; ++ks) { const bf16x8 A = *(const LAS bf16x8*)(Kt + (16 * w + fr) * 272 + (32 * ks + 8 * q) * 2);
#pragma unroll
            for (int nb = 0; nb < 4; ++nb) { const bf16x8 B = *(const LAS bf16x8*)(Vt + (16 * nb + fr) * 272 + (32 * ks + 8 * q) * 2); acc[nb] = __builtin_amdgcn_mfma_f32_16x16x32_bf16(A, B, acc[nb], 0, 0, 0); } }
        __syncthreads();
    }
    if (!smp) { float* So = p.out + OUT_SRET + (size_t)((seq * 2 + dir) * 8 + h) * 16384;
#pragma unroll
        for (int nb = 0; nb < 4; ++nb)
#pragma unroll
            for (int r = 0; r < 4; ++r) So[(16 * w + 4 * q + r) * 128 + 64 * eh + 16 * nb + fr] = acc[nb][r]; }
}

__device__ __forceinline__ void ret_out_unit(const Params& p, LAS unsigned char* lds, int gch, int h) {
    const int tid = threadIdx.x, lane = tid & 63, w = tid >> 6, q = lane >> 4, fr = lane & 15;
    LAS unsigned char* Qs = lds; LAS unsigned char* Ks = lds + 34816; LAS unsigned char* Vt = lds + 2 * 34816; LAS unsigned char* Pw = lds + 3 * 34816 + w * 4352;
    const bool smp = gch >= 64; const int seq = smp ? 32 + ((gch - 64) >> 4) : (gch >> 1); const int ch = smp ? ((gch - 64) & 15) : (gch & 1);
    const size_t row0 = (size_t)gch * 128;
    const bf16_t* Pq = (const bf16_t*)(p.ws + WS_P) + 2 * SLICE_ELEMS; const bf16_t* Pk = Pq + SLICE_ELEMS; const bf16_t* Pv = Pk + SLICE_ELEMS; bf16_t* Pg = (bf16_t*)(p.ws + WS_P) + 5 * SLICE_ELEMS;
    const bf16_t* Sbuf = (const bf16_t*)(p.ws + WS_H);
    const float* ropeC = (const float*)(p.ws + WS_ROPE); const float* ropeS = ropeC + 2048 * 64;
    const float lgf = -log1pf(expf(-p.ret_decay[h])) * LOG2E, lgb = -log1pf(expf(-p.ret_decay[8 + h])) * LOG2E;
#pragma unroll
    for (int rep = 0; rep < 2; ++rep) { const int it = tid + 512 * rep, fg = it & 7, tl = it >> 3, f0 = fg * 8; const size_t row = row0 + tl;
#pragma unroll
        for (int which = 0; which < 2; ++which) { const bf16_t* src = which ? Pk : Pq; LAS unsigned char* dst = which ? Ks : Qs; const float scl = which ? 0.08838834764831845f : 1.0f;
            const u32x4 a = *(const u32x4*)(src + row * 1024 + h * 128 + f0), b = *(const u32x4*)(src + row * 1024 + h * 128 + 64 + f0);
            const float x1[8] = {bflo(a.x), bfhi(a.x), bflo(a.y), bfhi(a.y), bflo(a.z), bfhi(a.z), bflo(a.w), bfhi(a.w)};
            const float x2[8] = {bflo(b.x), bfhi(b.x), bflo(b.y), bfhi(b.y), bflo(b.z), bfhi(b.z), bflo(b.w), bfhi(b.w)};
            float o1[8], o2[8];
            if (smp) { const int t = ch * 128 + tl; const f32x4 c0 = *(const f32x4*)(ropeC + t * 64 + f0), c1 = *(const f32x4*)(ropeC + t * 64 + f0 + 4), s0 = *(const f32x4*)(ropeS + t * 64 + f0), s1 = *(const f32x4*)(ropeS + t * 64 + f0 + 4);
#pragma unroll
                for (int j = 0; j < 8; ++j) { const float cs = j < 4 ? c0[j & 3] : c1[j & 3], sn = j < 4 ? s0[j & 3] : s1[j & 3]; o1[j] = (x1[j] * cs - x2[j] * sn) * scl; o2[j] = (x1[j] * sn + x2[j] * cs) * scl; } }
            else {
#pragma unroll
                for (int j = 0; j < 8; ++j) { o1[j] = x1[j] * scl; o2[j] = x2[j] * scl; } }
            u32x4 w1, w2; w1.x = pk2(o1[0], o1[1]); w1.y = pk2(o1[2], o1[3]); w1.z = pk2(o1[4], o1[5]); w1.w = pk2(o1[6], o1[7]);
            w2.x = pk2(o2[0], o2[1]); w2.y = pk2(o2[2], o2[3]); w2.z = pk2(o2[4], o2[5]); w2.w = pk2(o2[6], o2[7]);
            *(LAS u32x4*)(dst + tl * 272 + f0 * 2) = w1; *(LAS u32x4*)(dst + tl * 272 + (64 + f0) * 2) = w2; } }
#pragma unroll
    for (int rep = 0; rep < 2; ++rep) { const int it = tid + 512 * rep, tp = it & 63, eg = it >> 6, e0 = eg * 8; const size_t row = row0 + 2 * tp;
        const u32x4 va = *(const u32x4*)(Pv + row * 1024 + h * 128 + e0), vb = *(const u32x4*)(Pv + (row + 1) * 1024 + h * 128 + e0);
        const unsigned wa[4] = {va.x, va.y, va.z, va.w}, wb[4] = {vb.x, vb.y, vb.z, vb.w};
#pragma unroll
        for (int j = 0; j < 4; ++j) { *(LAS unsigned*)(Vt + (e0 + 2 * j) * 272 + tp * 4) = (wa[j] & 0xffffu) | (wb[j] << 16); *(LAS unsigned*)(Vt + (e0 + 2 * j + 1) * 272 + tp * 4) = (wa[j] >> 16) | (wb[j] & 0xffff0000u); } }
    __syncthreads();
    bf16x8 aQ[4];
#pragma unroll
    for (int ks = 0; ks < 4; ++ks) aQ[ks] = *(const LAS bf16x8*)(Qs + (16 * w + fr) * 272 + (32 * ks + 8 * q) * 2);
#pragma unroll
    for (int nb = 0; nb < 8; ++nb) { f32x4 s = (f32x4){0.f, 0.f, 0.f, 0.f};
#pragma unroll
        for (int ks = 0; ks < 4; ++ks) { const bf16x8 B = *(const LAS bf16x8*)(Ks + (16 * nb + fr) * 272 + (32 * ks + 8 * q) * 2); s = __builtin_amdgcn_mfma_f32_16x16x32_bf16(aQ[ks], B, s, 0, 0, 0); }
#pragma unroll
        for (int r = 0; r < 4; ++r) { const int dlt = (16 * w + 4 * q + r) - (16 * nb + fr);
            const float m = dlt > 0 ? exp2f(lgf * (float)dlt) : (dlt < 0 ? exp2f(lgb * (float)(-dlt)) : 2.0f);
            *(LAS bf16_t*)(Pw + (4 * q + r) * 272 + (16 * nb + fr) * 2) = f2bf(s[r] * m); } }
    LDS_FENCE(); __builtin_amdgcn_wave_barrier();
    f32x4 o[8];
#pragma unroll
    for (int eb = 0; eb < 8; ++eb) o[eb] = (f32x4){0.f, 0.f, 0.f, 0.f};
#pragma unroll
    for (int ks = 0; ks < 4; ++ks) { const bf16x8 A = *(const LAS bf16x8*)(Pw + fr * 272 + (32 * ks + 8 * q) * 2);
#pragma unroll
        for (int eb = 0; eb < 8; ++eb) { const bf16x8 B = *(const LAS bf16x8*)(Vt + (16 * eb + fr) * 272 + (32 * ks + 8 * q) * 2); o[eb] = __builtin_amdgcn_mfma_f32_16x16x32_bf16(A, B, o[eb], 0, 0, 0); } }
#pragma unroll
    for (int dir = 0; dir < 2; ++dir) { const bf16_t* Sd = Sbuf + (size_t)ret_slot(seq, h, dir, ch) * 16384; const float lg = dir ? lgb : lgf;
        float dec[4];
#pragma unroll
        for (int r = 0; r < 4; ++r) { const int tl = 16 * w + 4 * q + r; dec[r] = exp2f(lg * (float)(dir ? 128 - tl : tl + 1)); }
#pragma unroll
        for (int eb = 0; eb < 8; ++eb) { f32x4 s = (f32x4){0.f, 0.f, 0.f, 0.f};
#pragma unroll
            for (int ks = 0; ks < 4; ++ks) { const bf16x8 B = *(const bf16x8*)(Sd + (16 * eb + fr) * 128 + 32 * ks + 8 * q); s = __builtin_amdgcn_mfma_f32_16x16x32_bf16(aQ[ks], B, s, 0, 0, 0); }
#pragma unroll
            for (int r = 0; r < 4; ++r) o[eb][r] += dec[r] * s[r]; } }
    float rstd[4];
#pragma unroll
    for (int r = 0; r < 4; ++r) { float ss = 0.f;
#pragma unroll
        for (int eb = 0; eb < 8; ++eb) ss += o[eb][r] * o[eb][r];
        ss += __shfl_xor(ss, 1); ss += __shfl_xor(ss, 2); ss += __shfl_xor(ss, 4); ss += __shfl_xor(ss, 8);
        rstd[r] = 1.0f / sqrtf(ss * (1.0f / 128.0f) + EPSV); }
    LDS_FENCE(); __builtin_amdgcn_wave_barrier();
#pragma unroll
    for (int eb = 0; eb < 8; ++eb) { const int e = 16 * eb + fr; const float g = p.ret_norm_g[h * 128 + e];
#pragma unroll
        for (int r = 0; r < 4; ++r) { const size_t row = row0 + 16 * w + 4 * q + r; const float gt = bflo((unsigned)Pg[row * 1024 + h * 128 + e]);
            *(LAS bf16_t*)(Pw + (4 * q + r) * 272 + e * 2) = f2bf(o[eb][r] * rstd[r] * g * silu(gt)); } }
    LDS_FENCE(); __builtin_amdgcn_wave_barrier();
#pragma unroll
    for (int it = 0; it < 4; ++it) { const int rr = q + 4 * it; const u32x4 v = *(const LAS u32x4*)(Pw + rr * 272 + fr * 16);
        *(u32x4*)(Pg + (row0 + 16 * w + rr) * 1024 + h * 128 + fr * 8) = v; }
    __syncthreads();
}

template <bool FWD>
__device__ __forceinline__ void tile_scan(float (&a)[4][4], float (&b)[4][4], int q, int lane, float& Atot, float& Btot) {
    float As[4], Bs[4], At[4], Bt[4], Ae[4], Be[4];
#pragma unroll
    for (int mb = 0; mb < 4; ++mb) {
        if (FWD) { float A = a[mb][0], B = b[mb][0];
#pragma unroll
            for (int r = 1; r < 4; ++r) { B = B * a[mb][r] + b[mb][r]; A *= a[mb][r]; } As[mb] = A; Bs[mb] = B; }
        else { float A = a[mb][3], B = b[mb][3];
#pragma unroll
            for (int r = 2; r >= 0; --r) { B = B * a[mb][r] + b[mb][r]; A *= a[mb][r]; } As[mb] = A; Bs[mb] = B; }
    }
    const int n1 = FWD ? lane - 16 : lane + 16, n2 = FWD ? lane - 32 : lane + 32;
    const bool v1 = FWD ? (q >= 1) : (q <= 2), v2 = FWD ? (q >= 2) : (q <= 1);
#pragma unroll
    for (int mb = 0; mb < 4; ++mb) {
        const float A1 = __shfl(As[mb], n1), B1 = __shfl(Bs[mb], n1);
        if (v1) { Bs[mb] = B1 * As[mb] + Bs[mb]; As[mb] = A1 * As[mb]; }
        const float A2 = __shfl(As[mb], n2), B2 = __shfl(Bs[mb], n2);
        if (v2) { Bs[mb] = B2 * As[mb] + Bs[mb]; As[mb] = A2 * As[mb]; }
    }
    const int ntot = FWD ? (lane & 15) + 48 : (lane & 15);
#pragma unroll
    for (int mb = 0; mb < 4; ++mb) { At[mb] = __shfl(As[mb], ntot); Bt[mb] = __shfl(Bs[mb], ntot);
        const float ae = __shfl(As[mb], n1), be = __shfl(Bs[mb], n1); Ae[mb] = v1 ? ae : 1.0f; Be[mb] = v1 ? be : 0.0f; }
    float Ac = 1.0f, Bc = 0.0f;
#pragma unroll
    for (int i = 0; i < 4; ++i) { const int mb = FWD ? i : 3 - i;
        float cum = Ac * Ae[mb], hh = Bc * Ae[mb] + Be[mb];
#pragma unroll
        for (int j = 0; j < 4; ++j) { const int r = FWD ? j : 3 - j; hh = a[mb][r] * hh + b[mb][r]; cum = cum * a[mb][r]; b[mb][r] = hh; a[mb][r] = cum; }
        Bc = Bc * At[mb] + Bt[mb]; Ac = Ac * At[mb]; }
    Atot = Ac; Btot = Bc;
}
__device__ __forceinline__ void lru_pass1_unit(const Params& p, LAS unsigned char* lds, int gt, int h) {
    const int tid = threadIdx.x, lane = tid & 63, w = tid >> 6, q = lane >> 4, fr = lane & 15;
    LAS float* Uf = (LAS float*)lds;
    LAS unsigned char* Ub = lds + 33792;
    LAS unsigned char* Ot = lds + 33792 + 17408;
    const bf16_t* xa = (const bf16_t*)(p.ws + WS_P);
    const int T = gt < 128 ? 256 : 2048, t0 = gt < 128 ? (gt & 3) * 64 : ((gt - 128) & 31) * 64; const size_t row0 = (size_t)gt * 64;
    { const int c2 = tid & 63, tg = tid >> 6, hc = h * 128 + 2 * c2;
      const f32x2 w0 = *(const f32x2*)(p.lru_conv_w + hc), w1 = *(const f32x2*)(p.lru_conv_w + 1024 + hc), w2 = *(const f32x2*)(p.lru_conv_w + 2048 + hc), w3 = *(const f32x2*)(p.lru_conv_w + 3072 + hc), bb = *(const f32x2*)(p.lru_conv_b + hc);
      float x0[11], x1[11];
#pragma unroll
      for (int i = 0; i < 11; ++i) { const int tl = tg * 8 - 2 + i, tt = t0 + tl; unsigned v = 0u; if (tt >= 0 && tt < T) v = *(const unsigned*)(xa + (size_t)((long)row0 + tl) * 1024 + hc); x0[i] = bflo(v); x1[i] = bfhi(v); }
#pragma unroll
      for (int j = 0; j < 8; ++j) { const float u0 = w0[0] * x0[j] + w1[0] * x0[j + 1] + w2[0] * x0[j + 2] + w3[0] * x0[j + 3] + bb[0];
          const float u1 = w0[1] * x1[j] + w1[1] * x1[j + 1] + w2[1] * x1[j + 2] + w3[1] * x1[j + 3] + bb[1]; const int tl = tg * 8 + j;
          *(LAS f32x2*)(Uf + tl * 132 + 2 * c2) = (f32x2){u0, u1}; *(LAS unsigned*)(Ub + tl * 272 + 4 * c2) = pk2(u0, u1); } }
    __syncthreads();
    float ga[4][4][4];
    { bf16x8 aU[4][4];
#pragma unroll
      for (int mb = 0; mb < 4; ++mb)
#pragma unroll
          for (int ks = 0; ks < 4; ++ks) aU[mb][ks] = *(const LAS bf16x8*)(Ub + (16 * mb + fr) * 272 + (32 * ks + 8 * q) * 2);
      const bf16_t* Wg = (const bf16_t*)(p.ws + WS_WG) + (size_t)h * 512 * 128;
#pragma unroll
      for (int g = 0; g < 4; ++g) { bf16x8 bW[4];
#pragma unroll
          for (int ks = 0; ks < 4; ++ks) bW[ks] = *(const bf16x8*)(Wg + (size_t)(g * 128 + 16 * w + fr) * 128 + 32 * ks + 8 * q);
#pragma unroll
          for (int mb = 0; mb < 4; ++mb) { f32x4 s = (f32x4){0.f, 0.f, 0.f, 0.f};
#pragma unroll
              for (int ks = 0; ks < 4; ++ks) s = __builtin_amdgcn_mfma_f32_16x16x32_bf16(aU[mb][ks], bW[ks], s, 0, 0, 0);
              ga[g][mb][0] = s[0]; ga[g][mb][1] = s[1]; ga[g][mb][2] = s[2]; ga[g][mb][3] = s[3]; } } }
    const int hc = h * 128 + 16 * w + fr;
    const float kf = -8.0f * LOG2E * log1pf(expf(-p.lru_lambda[hc])), kb = -8.0f * LOG2E * log1pf(expf(-p.lru_lambda[1024 + hc]));
    const float brf = p.lru_b_r[hc], bif = p.lru_b_i[hc], brb = p.lru_b_r[1024 + hc], bib = p.lru_b_i[1024 + hc];
#pragma unroll
    for (int mb = 0; mb < 4; ++mb)
#pragma unroll
        for (int r = 0; r < 4; ++r) { const float uu = Uf[(16 * mb + 4 * q + r) * 132 + 16 * w + fr];
            const float af = exp2f(kf * sigm(ga[0][mb][r] + brf)), bf_ = sqrtf(fmaxf(1.0f - af * af, 0.0f)) * sigm(ga[1][mb][r] + bif) * uu;
            const float ab = exp2f(kb * sigm(ga[2][mb][r] + brb)), bb_ = sqrtf(fmaxf(1.0f - ab * ab, 0.0f)) * sigm(ga[3][mb][r] + bib) * uu;
            ga[0][mb][r] = af; ga[1][mb][r] = bf_; ga[2][mb][r] = ab; ga[3][mb][r] = bb_; }
    float Af, Bf, Ab, Bb;
    tile_scan<true>(ga[0], ga[1], q, lane, Af, Bf);
    tile_scan<false>(ga[2], ga[3], q, lane, Ab, Bb);
#pragma unroll
    for (int mb = 0; mb < 4; ++mb)
#pragma unroll
        for (int r = 0; r < 4; ++r) { const int off = (16 * mb + 4 * q + r) * 272 + (16 * w + fr) * 2;
            *(LAS bf16_t*)(Ot + off) = f2bf(ga[1][mb][r] + ga[3][mb][r]); *(LAS bf16_t*)(Ot + 17408 + off) = f2bf(ga[0][mb][r]); *(LAS bf16_t*)(Ot + 2 * 17408 + off) = f2bf(ga[2][mb][r]); }
    if (q == 0) { float* carr = (float*)(p.ws + WS_CARR);
        *(f32x2*)(carr + ((size_t)(gt * 2 + 0) * 1024 + hc) * 2) = (f32x2){Af, Bf}; *(f32x2*)(carr + ((size_t)(gt * 2 + 1) * 1024 + hc) * 2) = (f32x2){Ab, Bb}; }
    __syncthreads();
    bf16_t* L = (bf16_t*)p.out;
#pragma unroll
    for (int k = 0; k < 6; ++k) { const int idx = tid + 512 * k, tile = idx >> 10, rem = idx & 1023, row = rem >> 4, chk = rem & 15;
        const u32x4 v = *(const LAS u32x4*)(Ot + tile * 17408 + row * 272 + chk * 16);
        *(u32x4*)(L + (size_t)tile * SLICE_ELEMS + (row0 + row) * 1024 + h * 128 + chk * 8) = v; }
    __syncthreads();
}
__device__ __forceinline__ void lru_pass2_unit(const Params& p, int gt, int half) {
    const int tid = threadIdx.x, c4 = half * 512 + (tid & 127) * 4, rg = tid >> 7;
    const bool prm = gt < 128; const int seq = prm ? (gt >> 2) : 32 + ((gt - 128) >> 5); const int ti = prm ? (gt & 3) : ((gt - 128) & 31); const int nT = prm ? 4 : 32; const int gt0 = gt - ti;
    const float* carr = (const float*)(p.ws + WS_CARR);
    f32x4 hf = (f32x4){0.f, 0.f, 0.f, 0.f}, hb = hf;
    if (!prm) { hf = *(const f32x4*)(p.state_lru + (size_t)((seq - 32) * 2 + 0) * 1024 + c4); hb = *(const f32x4*)(p.state_lru + (size_t)((seq - 32) * 2 + 1) * 1024 + c4); }
    for (int k = 0; k < ti; ++k) { const float* cp = carr + ((size_t)((gt0 + k) * 2 + 0) * 1024 + c4) * 2; const f32x4 c0 = *(const f32x4*)cp, c1 = *(const f32x4*)(cp + 4);
        hf[0] = c0[0] * hf[0] + c0[1]; hf[1] = c0[2] * hf[1] + c0[3]; hf[2] = c1[0] * hf[2] + c1[1]; hf[3] = c1[2] * hf[3] + c1[3]; }
    for (int k = nT - 1; k > ti; --k) { const float* cp = carr + ((size_t)((gt0 + k) * 2 + 1) * 1024 + c4) * 2; const f32x4 c0 = *(const f32x4*)cp, c1 = *(const f32x4*)(cp + 4);
        hb[0] = c0[0] * hb[0] + c0[1]; hb[1] = c0[2] * hb[1] + c0[3]; hb[2] = c1[0] * hb[2] + c1[1]; hb[3] = c1[2] * hb[3] + c1[3]; }
    if (prm && rg == 0) {
        if (ti == nT - 1) { const float* cp = carr + ((size_t)(gt * 2 + 0) * 1024 + c4) * 2; const f32x4 c0 = *(const f32x4*)cp, c1 = *(const f32x4*)(cp + 4);
            *(f32x4*)(p.out + OUT_SLRU + (size_t)(seq * 2 + 0) * 1024 + c4) = (f32x4){c0[0] * hf[0] + c0[1], c0[2] * hf[1] + c0[3], c1[0] * hf[2] + c1[1], c1[2] * hf[3] + c1[3]}; }
        if (ti == 0) { const float* cp = carr + ((size_t)(gt * 2 + 1) * 1024 + c4) * 2; const f32x4 c0 = *(const f32x4*)cp, c1 = *(const f32x4*)(cp + 4);
            *(f32x4*)(p.out + OUT_SLRU + (size_t)(seq * 2 + 1) * 1024 + c4) = (f32x4){c0[0] * hb[0] + c0[1], c0[2] * hb[1] + c0[3], c1[0] * hb[2] + c1[1], c1[2] * hb[3] + c1[3]}; }
    }
    const bf16_t* L = (const bf16_t*)p.out; bf16_t* Pga = (bf16_t*)(p.ws + WS_P) + SLICE_ELEMS;
#pragma unroll 4
    for (int i = 0; i < 16; ++i) { const size_t off = ((size_t)gt * 64 + rg * 16 + i) * 1024 + c4;
        const u32x2 s = *(const u32x2*)(L + off), af = *(const u32x2*)(L + SLICE_ELEMS + off), ab = *(const u32x2*)(L + 2 * SLICE_ELEMS + off), g = *(const u32x2*)(Pga + off);
        const float y0 = (bflo(s.x) + bflo(af.x) * hf[0] + bflo(ab.x) * hb[0]) * silu(bflo(g.x)), y1 = (bfhi(s.x) + bfhi(af.x) * hf[1] + bfhi(ab.x) * hb[1]) * silu(bfhi(g.x));
        const float y2 = (bflo(s.y) + bflo(af.y) * hf[2] + bflo(ab.y) * hb[2]) * silu(bflo(g.y)), y3 = (bfhi(s.y) + bfhi(af.y) * hf[3] + bfhi(ab.y) * hb[3]) * silu(bfhi(g.y));
        u32x2 o; o.x = pk2(y0, y1); o.y = pk2(y2, y3); *(u32x2*)(Pga + off) = o; }
}

__device__ __forceinline__ void sconv_unit(const Params& p, int gt, int half) {
    const int tid = threadIdx.x, c4 = half * 512 + (tid & 127) * 4, rg = tid >> 7;
    const int T = gt < 128 ? 256 : 2048, t0 = (gt < 128 ? (gt & 3) : ((gt - 128) & 31)) * 64;
    const bf16_t* P = (const bf16_t*)(p.ws + WS_P); const bf16_t* Pb = P + 2 * SLICE_ELEMS; const bf16_t* Pc = P + 3 * SLICE_ELEMS; const bf16_t* Px = P + 4 * SLICE_ELEMS; bf16_t* Pg = (bf16_t*)(p.ws + WS_P) + 5 * SLICE_ELEMS;
    const f32x4 w0 = *(const f32x4*)(p.sconv_w + c4), w1 = *(const f32x4*)(p.sconv_w + 1024 + c4), w2 = *(const f32x4*)(p.sconv_w + 2048 + c4);
    const int tl0 = rg * 16;
    f32x4 vprev, vcur, vnext;
    auto loadv = [&](int tl) -> f32x4 { const int tt = t0 + tl; if (tt < 0 || tt >= T) return (f32x4){0.f, 0.f, 0.f, 0.f};
        const size_t off = (size_t)((long)gt * 64 + tl) * 1024 + c4; const u32x2 c = *(const u32x2*)(Pc + off), x = *(const u32x2*)(Px + off);
        return (f32x4){bflo(c.x) * bflo(x.x), bfhi(c.x) * bfhi(x.x), bflo(c.y) * bflo(x.y), bfhi(c.y) * bfhi(x.y)}; };
    vprev = loadv(tl0 - 1); vcur = loadv(tl0);
#pragma unroll 4
    for (int i = 0; i < 16; ++i) { const int tl = tl0 + i; vnext = loadv(tl + 1);
        const size_t off = ((size_t)gt * 64 + tl) * 1024 + c4; const u32x2 b = *(const u32x2*)(Pb + off), g = *(const u32x2*)(Pg + off);
        const f32x4 cv = w0 * vprev + w1 * vcur + w2 * vnext;
        u32x2 o; o.x = pk2(bflo(b.x) * cv[0] * silu(bflo(g.x)), bfhi(b.x) * cv[1] * silu(bfhi(g.x))); o.y = pk2(bflo(b.y) * cv[2] * silu(bflo(g.y)), bfhi(b.y) * cv[3] * silu(bfhi(g.y)));
        *(u32x2*)(Pg + off) = o; vprev = vcur; vcur = vnext; }
}

__device__ __forceinline__ void final_norm_phase(const Params& p) {
    const int tid = threadIdx.x, lane = tid & 63, wave = tid >> 6;
    for (int row = blockIdx.x * 8 + wave; row < NTOK; row += gridDim.x * 8) {
        float* xr = p.out + (size_t)row * D; f32x4 v[8]; float ss = 0.f;
#pragma unroll
        for (int j = 0; j < 8; ++j) { v[j] = *(const f32x4*)(xr + 4 * lane + 256 * j); ss += (v[j][0] * v[j][0] + v[j][1] * v[j][1]) + (v[j][2] * v[j][2] + v[j][3] * v[j][3]); }
        const float rstd = 1.0f / sqrtf(wave_sum(ss) * (1.0f / 2048.0f) + EPSV);
#pragma unroll
        for (int j = 0; j < 8; ++j) { const int col = 4 * lane + 256 * j; const f32x4 g = *(const f32x4*)(p.final_norm_g + col); *(f32x4*)(xr + col) = v[j] * rstd * g; }
    }
}

constexpr int NPH = 12;
__global__ void __launch_bounds__(512, 2) mk_fwd(Params p) {
    extern __shared__ __attribute__((aligned(16))) unsigned char lds_raw[];
    LAS unsigned char* lds = (LAS unsigned char*)lds_raw;
    const int G = gridDim.x, bid = blockIdx.x;
#define IN(k) (p.ph_lo <= (k) && (k) < p.ph_hi)
#define SEAM(k) do { if (IN(k) && IN((k) + 1)) { cg::this_grid().sync(); } } while (0)
    const char* Hb = (const char*)(p.ws + WS_H);
    bf16_t* Pb = (bf16_t*)(p.ws + WS_P);
    const float* mod = (const float*)(p.ws + WS_MOD);

    if (IN(0)) ph0_prep(p, lds);
    SEAM(0);
    if (IN(1)) normmod_phase(p, p.x_prompt, p.x_sample - (size_t)NPR * D, 0);
    SEAM(1);
    if (IN(2)) { pg8::GCfg g{2048, 2048, 32, 1 << 30, 0l}; pg8::SchedInProj S{Hb, (const char*)(p.ws + WS_WIN), G, bid}; pg8::EpiBf16Store E{Pb, 1024};
        pg8::gemm_phase(lds, g, S, E); }
    SEAM(2);
    if (IN(3)) {
        for (int ci = bid; ci < 1280; ci += G) {
            if (ci < 256) { const int eh = ci & 1, dir = (ci >> 1) & 1, h = (ci >> 2) & 7, b = ci >> 5; ret_chain(p, lds, 32 + b, h, dir, eh); }
            else { const int cj = ci - 256; const int eh = cj & 1, dir = (cj >> 1) & 1, h = (cj >> 2) & 7, b = cj >> 5; ret_chain(p, lds, b, h, dir, eh); } }
        for (int u = bid; u < 3072; u += G) lru_pass1_unit(p, lds, u >> 3, u & 7);
    }
    SEAM(3);
    if (IN(4)) {
        for (int u = bid; u < 1536; u += G) ret_out_unit(p, lds, u >> 3, u & 7);
        for (int u = bid; u < 768; u += G) lru_pass2_unit(p, u >> 1, u & 1);
    }
    SEAM(4);
    if (IN(5)) { pg8::GCfg g{1024, 2048, 32, 16, (long)(4 * SLICE_ELEMS * 2) - 2048l}; pg8::SchedOutProj S{(const char*)(Pb + SLICE_ELEMS), (const char*)(p.ws + WS_WOUT), G, bid};
        pg8::EpiResid E{p.x_prompt, p.x_sample - (size_t)NPR * D, p.out, mod + 4096};
        pg8::gemm_phase(lds, g, S, E); }
    SEAM(5);
    if (IN(6)) normmod_phase(p, p.out, p.out, 1);
    SEAM(6);
    if (IN(7)) { pg8::GCfg g{2048, 2048, 32, 1 << 30, 0l}; pg8::SchedInProj S{Hb, (const char*)(p.ws + WS_WIN) + (size_t)6144 * 2048 * 2, G, bid}; pg8::EpiBf16Store E{Pb, 1024};
        pg8::gemm_phase(lds, g, S, E); }
    SEAM(7);
    if (IN(8)) {
        bf16_t* PQT = (bf16_t*)(p.ws + WS_H);
        { pg8::GCfg g{256, 1024, 4, 1 << 30, 0l}; pg8::SchedF1 S{(const char*)(p.ws + WS_TAB1), (const char*)(Pb + (size_t)NPR * 1024), G, bid, 2048, 8, (long)32 * 1024 * 512}; pg8::EpiBf16Store E{PQT, 4096};
          pg8::gemm_phase(lds, g, S, E); }
        { pg8::GCfg g{256, 1024, 4, 1 << 30, 0l}; pg8::SchedF1 S{(const char*)(p.ws + WS_TAB1), (const char*)Pb, G, bid, 256, 32, 0l}; pg8::EpiBf16Store E{PQT, 512};
          pg8::gemm_phase(lds, g, S, E); }
        for (int u = bid; u < 768; u += G) sconv_unit(p, u >> 1, u & 1);
    }
    SEAM(8);
    if (IN(9)) {
        const char* PQT = (const char*)(p.ws + WS_H);
        { pg8::GCfg g{4096, 4096, 64, 1 << 30, 0l}; pg8::SchedF2 S{(const char*)(p.ws + WS_TAB2S), PQT + (size_t)32 * 1024 * 512 * 2, G, bid, 2048, 8, NPR}; pg8::EpiSiluInPlace E{Pb};
          pg8::gemm_phase(lds, g, S, E); }
        { pg8::GCfg g{512, 512, 8, 1 << 30, 0l}; pg8::SchedF2 S{(const char*)(p.ws + WS_TAB2P), PQT, G, bid, 256, 32, 0}; pg8::EpiSiluInPlace E{Pb};
          pg8::gemm_phase(lds, g, S, E); }
    }
    SEAM(9);
    if (IN(10)) { pg8::GCfg g{1024, 2048, 32, 16, (long)(4 * SLICE_ELEMS * 2) - 2048l}; pg8::SchedOutProj S{(const char*)(Pb + SLICE_ELEMS), (const char*)(p.ws + WS_WOUT) + (size_t)2048 * 2048 * 2, G, bid};
        pg8::EpiResid E{p.out, p.out, p.out, mod + 9 * 6144 + 4096};
        pg8::gemm_phase(lds, g, S, E); }
    SEAM(10);
    if (IN(11)) final_norm_phase(p);
#undef IN
#undef SEAM
}

extern "C" void kernel_launch(void* const* d_in, const int* in_sizes, int n_in, void* d_out, int out_size, void* d_ws, size_t ws_size, hipStream_t stream) {
    static int grid = 0;
    if (grid == 0) {
        int dev = 0, cus = 0, per_cu = 0;
        if (n_in != 22 || ws_size < WS_END) { fprintf(stderr, "kernel_launch: unexpected n_in %d / ws_size %zu (need %zu)\n", n_in, ws_size, (size_t)WS_END); grid = -1; return; }
        hipGetDevice(&dev); hipDeviceGetAttribute(&cus, hipDeviceAttributeMultiprocessorCount, dev);
        if (hipFuncSetAttribute((const void*)mk_fwd, hipFuncAttributeMaxDynamicSharedMemorySize, LDS_BYTES) != hipSuccess) { fprintf(stderr, "kernel_launch: hipFuncSetAttribute failed\n"); grid = -1; return; }
        if (hipOccupancyMaxActiveBlocksPerMultiprocessor(&per_cu, (const void*)mk_fwd, 512, LDS_BYTES) != hipSuccess || per_cu < 1) { fprintf(stderr, "kernel_launch: occupancy query says %d blocks per CU\n", per_cu); (void)hipGetLastError(); per_cu = 1; }
        grid = cus;
        (void)per_cu;
    }
    if (grid < 0) return;
    Params p{};
    const float** pp = (const float**)&p;
    for (int i = 0; i < 22; ++i) pp[i] = (const float*)d_in[i];
    p.out = (float*)d_out; p.ws = (unsigned char*)d_ws;
#if MK_PER_PHASE_LAUNCH
    for (int ph = 0; ph < NPH; ++ph) { p.ph_lo = ph; p.ph_hi = ph + 1; hipLaunchKernelGGL(mk_fwd, dim3(grid), dim3(512), LDS_BYTES, stream, p); }
#else
    p.ph_lo = 0; p.ph_hi = NPH;
    void* args[] = {&p};
    hipError_t e = hipLaunchCooperativeKernel((const void*)mk_fwd, dim3(grid), dim3(512), args, LDS_BYTES, stream);
    if (e != hipSuccess) fprintf(stderr, "kernel_launch: cooperative launch failed: %s (grid %d)\n", hipGetErrorString(e), grid);
#endif
}
```

```cpp
#include <hip/hip_runtime.h>
#include <hip/hip_cooperative_groups.h>
#include <cstdio>
namespace cg = cooperative_groups;

#ifndef MK_PER_PHASE_LAUNCH
#define MK_PER_PHASE_LAUNCH 0
#endif

#define LAS __attribute__((address_space(3)))
typedef unsigned short bf16_t;
typedef short bf16x8 __attribute__((ext_vector_type(8)));
typedef float f32x4 __attribute__((ext_vector_type(4)));
typedef float f32x2 __attribute__((ext_vector_type(2)));
typedef unsigned u32x4 __attribute__((ext_vector_type(4)));
typedef unsigned u32x2 __attribute__((ext_vector_type(2)));

constexpr int D = 2048, WB = 1024, NTOK = 24576, NPR = 8192;
constexpr int LDS_BYTES = 147456;
constexpr float EPSV = 1e-6f;
constexpr float LOG2E = 1.4426950408889634f;
constexpr size_t SLICE_ELEMS = (size_t)NTOK * WB;

constexpr size_t WS_CTL = 0;
constexpr size_t WS_MOD = 65536;
constexpr size_t WS_WG = WS_MOD + 524288;
constexpr size_t WS_ROPE = WS_WG + (1u << 20);
constexpr size_t WS_TAB1 = WS_ROPE + (1u << 20);
constexpr size_t WS_TAB2P = WS_TAB1 + (256u << 10);
constexpr size_t WS_TAB2S = WS_TAB2P + (256u << 10);
constexpr size_t WS_CARR = WS_TAB2S + (16u << 20);
constexpr size_t WS_WIN = WS_CARR + (6u << 20);
constexpr size_t WS_WOUT = WS_WIN + (48u << 20);
constexpr size_t WS_P = WS_WOUT + (16u << 20);
constexpr size_t WS_H = WS_P + (288ull << 20);
constexpr size_t WS_END = WS_H + (96ull << 20);
constexpr size_t OUT_SLRU = (size_t)NTOK * D;
constexpr size_t OUT_SRET = OUT_SLRU + 65536;

struct Params {
    const float *x_prompt, *x_sample, *state_lru, *state_ret, *c, *c_ctx, *norm_g, *ada_w, *ada_b, *w_in, *w_out,
        *lru_conv_w, *lru_conv_b, *lru_lambda, *lru_w_r, *lru_b_r, *lru_w_i, *lru_b_i, *ret_decay, *ret_norm_g, *sconv_w, *final_norm_g;
    float* out; unsigned char* ws; int ph_lo, ph_hi;
};

__device__ __forceinline__ unsigned pk2(float lo, float hi) { unsigned r; asm("v_cvt_pk_bf16_f32 %0, %1, %2" : "=v"(r) : "v"(lo), "v"(hi)); return r; }
__device__ __forceinline__ bf16_t f2bf(float f) { return (bf16_t)(pk2(f, 0.f) & 0xffffu); }
__device__ __forceinline__ float bflo(unsigned u) { return __uint_as_float(u << 16); }
__device__ __forceinline__ float bfhi(unsigned u) { return __uint_as_float(u & 0xffff0000u); }
__device__ __forceinline__ float sigm(float x) { return __builtin_amdgcn_rcpf(1.f + __expf(-x)); }
__device__ __forceinline__ float silu(float x) { return x * sigm(x); }
__device__ __forceinline__ float wave_sum(float v) {
#pragma unroll
    for (int o = 1; o < 64; o <<= 1) v += __shfl_xor(v, o);
    return v;
}
#define LDS_FENCE() asm volatile("s_waitcnt lgkmcnt(0)" ::: "memory")

namespace pg8 {
constexpr int BM = 256, BK = 64, HALF = 128, HTB = HALF * BK * 2, STAGE_BYTES = 8 * HTB;
__device__ __forceinline__ int lds_byte(int r, int c) { const int st = (r >> 4) * 2 + (c >> 5), rr = r & 15, cc = c & 31, ob = rr * 64 + cc * 2; return st * 1024 + (ob ^ (((ob >> 9) & 1) << 5)); }
__device__ __forceinline__ void stage_rc(int b, int& R, int& C) { const int st = b / 1024, sb = b % 1024, swz = sb ^ (((sb >> 9) & 1) << 5); R = (st >> 1) * 16 + swz / 64; C = (st & 1) * 32 + (swz % 64) / 2; }
__device__ __forceinline__ int perm32(int rho) { const int n = rho >> 4, i = rho & 15; return 8 * (i >> 2) + 4 * n + (i & 3); }

struct GUnit { const char* A; const char* B; long coff; int aux, aux2; };
struct GCfg { int lda, ldb, nt, ksplit; long ksoff; };

template <class Epi, class Sched>
__device__ __forceinline__ void gemm_phase(LAS unsigned char* lds, const GCfg g, const Sched& S, const Epi& E) {
    const int tid = threadIdx.x, wid = __builtin_amdgcn_readfirstlane(tid >> 6), lane = tid & 63, wr = wid >> 2, wc = wid & 3, fr = lane & 15, fq = lane >> 4;
    const int nt = g.nt;
    unsigned voffA[2], voffB[2];
#pragma unroll
    for (int i = 0; i < 2; ++i) { int R, C; stage_rc(tid * 16 + i * 8192, R, C); const int Rb = Epi::PERM ? ((R & ~31) + perm32(R & 31)) : R;
        voffA[i] = (unsigned)(R * g.lda + C) * 2u; voffB[i] = (unsigned)(Rb * g.ldb + C) * 2u; }
    const size_t kstep = (size_t)(BK * 2);
    const size_t hstepA = (size_t)HALF * g.lda * 2, hstepB = (size_t)HALF * g.ldb * 2;
    const unsigned ldsw = (unsigned)wid * 1024u;
    const int aoff = lds_byte(wr * 64 + fr, fq * 8), boff = lds_byte(wc * 32 + fr, fq * 8);
#define PG8_AKT(base, t) ((base) + (size_t)(t) * kstep + ((t) >= g.ksplit ? g.ksoff : 0l))
#define PG8_SA(b, h) (((b) * 2 + (h)) * HTB)
#define PG8_SB(b, h) ((4 + (b) * 2 + (h)) * HTB)
#define PG8_STAGE(bufoff, gbase, voff) do { _Pragma("unroll") for (int _i = 0; _i < 2; ++_i) \
        __builtin_amdgcn_global_load_lds((const unsigned*)((const char*)(gbase) + (voff)[_i]), (LAS unsigned*)(lds + (bufoff) + ldsw + _i * 8192), 16, 0, 0); } while (0)
#define PG8_LDA(dst, b, h) do { _Pragma("unroll") for (int m = 0; m < 4; ++m) _Pragma("unroll") for (int k = 0; k < 2; ++k) dst[m][k] = *(const LAS bf16x8*)(lds + PG8_SA(b, h) + aoff + m * 2048 + k * 1024); } while (0)
#define PG8_LDB(dst, b, h) do { _Pragma("unroll") for (int n = 0; n < 2; ++n) _Pragma("unroll") for (int k = 0; k < 2; ++k) dst[n][k] = *(const LAS bf16x8*)(lds + PG8_SB(b, h) + boff + n * 2048 + k * 1024); } while (0)
#define PG8_MMA(ai, bj, At, Bt) do { __builtin_amdgcn_s_setprio(1); _Pragma("unroll") for (int m = 0; m < 4; ++m) _Pragma("unroll") for (int n = 0; n < 2; ++n) _Pragma("unroll") for (int k = 0; k < 2; ++k) \
        acc[ai][bj][m][n] = __builtin_amdgcn_mfma_f32_16x16x32_bf16(Bt[n][k], At[m][k], acc[ai][bj][m][n], 0, 0, 0); __builtin_amdgcn_s_setprio(0); } while (0)
#define PG8_WAIT_V(n) asm volatile("s_waitcnt vmcnt(" #n ")" ::: "memory")
#define PG8_WAIT_L(n) asm volatile("s_waitcnt lgkmcnt(" #n ")" ::: "memory")
#define PG8_BAR __builtin_amdgcn_s_barrier()
#define PG8_SCHED __builtin_amdgcn_sched_barrier(0)
    GUnit cur, nxt; int ui = 0;
    if (!S.next(0, cur)) return;
    f32x4 acc[2][2][4][2];
#pragma unroll
    for (int a = 0; a < 2; ++a)
#pragma unroll
        for (int b = 0; b < 2; ++b)
#pragma unroll
            for (int m = 0; m < 4; ++m)
#pragma unroll
                for (int n = 0; n < 2; ++n) acc[a][b][m][n] = (f32x4){0.f, 0.f, 0.f, 0.f};
    bf16x8 At[4][2], B0[2][2], B1[2][2];
    const char* cA = cur.A; const char* cB = cur.B;
    PG8_STAGE(PG8_SB(0, 0), cB, voffB); PG8_STAGE(PG8_SA(0, 0), cA, voffA); PG8_STAGE(PG8_SB(0, 1), cB + hstepB, voffB); PG8_STAGE(PG8_SA(0, 1), cA + hstepA, voffA);
    if (wr == 1) PG8_BAR;
    PG8_WAIT_V(4); PG8_BAR;
    PG8_STAGE(PG8_SB(1, 0), cB + kstep, voffB); PG8_STAGE(PG8_SA(1, 0), cA + kstep, voffA); PG8_STAGE(PG8_SB(1, 1), cB + hstepB + kstep, voffB);
    PG8_WAIT_V(6); PG8_BAR;
    for (;;) {
        const bool has_next = S.next(ui + 1, nxt);
        const char* nA = has_next ? nxt.A : cA; const char* nB = has_next ? nxt.B : cB;
        for (int t = 0; t < nt; t += 2) {
            const bool last = (t == nt - 2);
            const char* a1 = PG8_AKT(cA, t + 1);
            const char* a2 = last ? nA : PG8_AKT(cA, t + 2); const char* b2 = last ? nB : cB + (size_t)(t + 2) * kstep;
            const char* a3 = a2 + kstep; const char* b3 = b2 + kstep;
            PG8_LDB(B0, 0, 0); PG8_SCHED; PG8_LDA(At, 0, 0); PG8_STAGE(PG8_SA(1, 1), a1 + hstepA, voffA);
            PG8_WAIT_L(8); PG8_BAR; PG8_WAIT_L(0); PG8_MMA(0, 0, At, B0); PG8_BAR; PG8_SCHED;
            PG8_LDB(B1, 0, 1); PG8_STAGE(PG8_SB(0, 0), b2, voffB);
            PG8_BAR; PG8_WAIT_L(0); PG8_MMA(0, 1, At, B1); PG8_BAR;
            PG8_LDA(At, 0, 1); PG8_STAGE(PG8_SA(0, 0), a2, voffA);
            PG8_BAR; PG8_WAIT_L(0); PG8_MMA(1, 0, At, B0); PG8_BAR; PG8_SCHED;
            PG8_STAGE(PG8_SB(0, 1), b2 + hstepB, voffB);
            PG8_WAIT_V(6); PG8_BAR; PG8_MMA(1, 1, At, B1); PG8_BAR;
            PG8_LDB(B0, 1, 0); PG8_SCHED; PG8_LDA(At, 1, 0); PG8_STAGE(PG8_SA(0, 1), a2 + hstepA, voffA);
            PG8_WAIT_L(8); PG8_BAR; PG8_WAIT_L(0); PG8_MMA(0, 0, At, B0); PG8_BAR; PG8_SCHED;
            PG8_LDB(B1, 1, 1); PG8_STAGE(PG8_SB(1, 0), b3, voffB);
            PG8_BAR; PG8_WAIT_L(0); PG8_MMA(0, 1, At, B1); PG8_BAR;
            PG8_LDA(At, 1, 1); PG8_STAGE(PG8_SA(1, 0), a3, voffA);
            PG8_BAR; PG8_WAIT_L(0); PG8_MMA(1, 0, At, B0); PG8_BAR; PG8_SCHED;
            PG8_STAGE(PG8_SB(1, 1), b3 + hstepB, voffB);
            PG8_WAIT_V(6); PG8_BAR; PG8_MMA(1, 1, At, B1); PG8_BAR;
        }
        E(acc, cur, wr, wc, fr, fq);
        if (!has_next) break;
#pragma unroll
        for (int a = 0; a < 2; ++a)
#pragma unroll
            for (int b = 0; b < 2; ++b)
#pragma unroll
                for (int m = 0; m < 4; ++m)
#pragma unroll
                    for (int n = 0; n < 2; ++n) acc[a][b][m][n] = (f32x4){0.f, 0.f, 0.f, 0.f};
        cur = nxt; cA = nA; cB = nB; ++ui;
    }
    PG8_WAIT_V(0);
    if (wr == 0) PG8_BAR;
    PG8_BAR;
#undef PG8_AKT
#undef PG8_SA
#undef PG8_SB
#undef PG8_STAGE
#undef PG8_LDA
#undef PG8_LDB
#undef PG8_MMA
#undef PG8_WAIT_V
#undef PG8_WAIT_L
#undef PG8_BAR
#undef PG8_SCHED
}

__device__ __forceinline__ bool mn_order(int i, int G, int c, int nM, int nN, int& pm, int& pn) {
    const int nwg = nM * nN; const long L = (long)i * G + c; if (L >= nwg) return false;
    int wgid = (int)L; { const int q = nwg / 8, r = nwg % 8, xcd = wgid % 8, off = wgid / 8; wgid = (xcd < r ? xcd * (q + 1) : r * (q + 1) + (xcd - r) * q) + off; }
    const int nig = 8 * nN, gid = wgid / nig, fm = gid * 8, gsz = (nM - fm) < 8 ? (nM - fm) : 8;
    pm = fm + ((wgid % nig) % gsz); pn = (wgid % nig) / gsz; return true;
}
struct SchedInProj {
    const char* A; const char* B; int G, c;
    __device__ __forceinline__ bool next(int i, GUnit& u) const { int pm, pn; if (!mn_order(i, G, c, NTOK / 256, 24, pm, pn)) return false;
        u.A = A + (size_t)pm * 256 * 2048 * 2; u.B = B + (size_t)pn * 256 * 2048 * 2; u.coff = (long)((size_t)(pn >> 2) * SLICE_ELEMS + (size_t)pm * 256 * 1024 + (pn & 3) * 256); u.aux = 0; u.aux2 = 0; return true; }
};
struct SchedOutProj {
    const char* A; const char* B; int G, c;
    __device__ __forceinline__ bool next(int i, GUnit& u) const { int pm, pn; if (!mn_order(i, G, c, NTOK / 256, 8, pm, pn)) return false;
        u.A = A + (size_t)pm * 256 * 1024 * 2; u.B = B + (size_t)pn * 256 * 2048 * 2; u.coff = (long)((size_t)pm * 256 * 2048 + pn * 256);
        const int r0 = pm * 256; u.aux = r0 < NPR ? 8 : ((r0 - NPR) >> 11); u.aux2 = r0 >= NPR; return true; }
};
struct SchedF1 {
    const char* Tab1; const char* X0  ; int G, c, T, nb; long pqt0;
    __device__ __forceinline__ bool next(int i, GUnit& u) const { const int ntn = T >> 8; const long L = (long)i * G + c; if (L >= (long)nb * 8 * ntn) return false;
        const int tn = (int)(L % ntn), pm = (int)((L / ntn) & 1), gq = (int)((L / (2 * ntn)) & 3), b = (int)(L / (8 * ntn));
        u.A = Tab1 + (size_t)pm * 256 * 256 * 2; u.B = X0 + ((size_t)(b * T + tn * 256) * 1024 + gq * 256) * 2;
        u.coff = pqt0 + (long)(b * 1024 + gq * 256) * (2 * T) + (long)pm * T + tn * 256; u.aux = 0; u.aux2 = 0; return true; }
};
struct SchedF2 {
    const char* Tab2; const char* PQT0; int G, c, T, nb, rowbase;
    __device__ __forceinline__ bool next(int i, GUnit& u) const { const int nm = T >> 8; const long L = (long)i * G + c; if (L >= (long)nb * 4 * nm) return false;
        const int pm = (int)(L % nm), pn = (int)((L / nm) & 3), b = (int)(L / (4 * nm));
        u.A = Tab2 + (size_t)pm * 256 * (2 * T) * 2; u.B = PQT0 + ((size_t)(b * 1024 + pn * 256) * (2 * T)) * 2;
        u.coff = (long)(SLICE_ELEMS + (size_t)(rowbase + b * T + pm * 256) * 1024 + pn * 256); u.aux = 0; u.aux2 = 0; return true; }
};

struct EpiBf16Store {
    static constexpr bool PERM = true;
    bf16_t* O; int ldc;
    __device__ __forceinline__ void operator()(const f32x4 (&acc)[2][2][4][2], const GUnit& u, int wr, int wc, int fr, int fq) const {
        bf16_t* base = O + u.coff + (size_t)(wr * 64 + fr) * ldc + wc * 32 + 8 * fq;
#pragma unroll
        for (int ai = 0; ai < 2; ++ai)
#pragma unroll
            for (int m = 0; m < 4; ++m) { bf16_t* rowp = base + (size_t)(ai * HALF + m * 16) * ldc;
#pragma unroll
                for (int bj = 0; bj < 2; ++bj) { const f32x4 v0 = acc[ai][bj][m][0], v1 = acc[ai][bj][m][1];
                    u32x4 w; w.x = pk2(v0[0], v0[1]); w.y = pk2(v0[2], v0[3]); w.z = pk2(v1[0], v1[1]); w.w = pk2(v1[2], v1[3]);
                    *(u32x4*)(rowp + bj * HALF) = w; } }
    }
};
struct EpiSiluInPlace {
    static constexpr bool PERM = true;
    bf16_t* O;
    __device__ __forceinline__ void operator()(const f32x4 (&acc)[2][2][4][2], const GUnit& u, int wr, int wc, int fr, int fq) const {
        bf16_t* base = O + u.coff + (size_t)(wr * 64 + fr) * 1024 + wc * 32 + 8 * fq;
#pragma unroll
        for (int ai = 0; ai < 2; ++ai)
#pragma unroll
            for (int m = 0; m < 4; ++m) { bf16_t* rowp = base + (size_t)(ai * HALF + m * 16) * 1024;
#pragma unroll
                for (int bj = 0; bj < 2; ++bj) { const f32x4 v0 = acc[ai][bj][m][0], v1 = acc[ai][bj][m][1];
                    const u32x4 gv = *(const u32x4*)(rowp + bj * HALF);
                    u32x4 w; w.x = pk2(v0[0] * silu(bflo(gv.x)), v0[1] * silu(bfhi(gv.x))); w.y = pk2(v0[2] * silu(bflo(gv.y)), v0[3] * silu(bfhi(gv.y)));
                    w.z = pk2(v1[0] * silu(bflo(gv.z)), v1[1] * silu(bfhi(gv.z))); w.w = pk2(v1[2] * silu(bflo(gv.w)), v1[3] * silu(bfhi(gv.w)));
                    *(u32x4*)(rowp + bj * HALF) = w; } }
    }
};
struct EpiResid {
    static constexpr bool PERM = false;
    const float* xin0; const float* xin1; float* out; const float* gate;
    __device__ __forceinline__ void operator()(const f32x4 (&acc)[2][2][4][2], const GUnit& u, int wr, int wc, int fr, int fq) const {
        const size_t off0 = (size_t)u.coff + (size_t)(wr * 64 + fr) * 2048 + wc * 32 + 4 * fq;
        const int col0 = (int)(u.coff & 2047) + wc * 32 + 4 * fq;
        const float* xb = u.aux2 ? xin1 : xin0; const float* gp = gate + (size_t)u.aux * 6144 + col0;
        f32x4 gv[2][2];
#pragma unroll
        for (int bj = 0; bj < 2; ++bj)
#pragma unroll
            for (int n = 0; n < 2; ++n) gv[bj][n] = *(const f32x4*)(gp + bj * HALF + n * 16);
#pragma unroll
        for (int ai = 0; ai < 2; ++ai)
#pragma unroll
            for (int m = 0; m < 4; ++m) { const size_t off = off0 + (size_t)(ai * HALF + m * 16) * 2048;
#pragma unroll
                for (int bj = 0; bj < 2; ++bj)
#pragma unroll
                    for (int n = 0; n < 2; ++n) { const f32x4 xv = *(const f32x4*)(xb + off + bj * HALF + n * 16);
                        *(f32x4*)(out + off + bj * HALF + n * 16) = xv + gv[bj][n] * acc[ai][bj][m][n]; } }
    }
};
}

__device__ __forceinline__ void mod_unit(const Params& p, LAS unsigned char* lds, int u) {
    const int tid = threadIdx.x, lane = tid & 63, wave = tid >> 6;
    LAS float* scond = (LAS float*)lds;
    for (int i = tid; i < 9 * 2048; i += 512) { const int ci = i >> 11, k = i & 2047; const float v = ci < 8 ? p.c[ci * 2048 + k] : p.c_ctx[k]; scond[i] = silu(v); }
    __syncthreads();
    const int l = u / 48, n0 = (u % 48) * 128, ct = lane & 31, rg = 2 * wave + (lane >> 5);
    const float* Wp = p.ada_w + (size_t)l * 2048 * 6144 + n0 + ct * 4;
    float acc[9][4];
#pragma unroll
    for (int ci = 0; ci < 9; ++ci)
#pragma unroll
        for (int j = 0; j < 4; ++j) acc[ci][j] = 0.f;
#pragma unroll 8
    for (int k = rg; k < 2048; k += 16) {
        const f32x4 w = *(const f32x4*)(Wp + (size_t)k * 6144);
#pragma unroll
        for (int ci = 0; ci < 9; ++ci) { const float s = scond[ci * 2048 + k]; acc[ci][0] += s * w[0]; acc[ci][1] += s * w[1]; acc[ci][2] += s * w[2]; acc[ci][3] += s * w[3]; }
    }
#pragma unroll
    for (int ci = 0; ci < 9; ++ci)
#pragma unroll
        for (int j = 0; j < 4; ++j) acc[ci][j] += __shfl_xor(acc[ci][j], 32);
    __syncthreads();
    LAS float* red = (LAS float*)lds;
    if (lane < 32) {
#pragma unroll
        for (int ci = 0; ci < 9; ++ci)
#pragma unroll
            for (int j = 0; j < 4; ++j) red[(wave * 32 + ct) * 36 + ci * 4 + j] = acc[ci][j];
    }
    __syncthreads();
    float* mod = (float*)(p.ws + WS_MOD);
    for (int o = tid; o < 9 * 128; o += 512) { const int ci = o >> 7, col = o & 127, ct2 = col >> 2, j = col & 3; float s = 0.f;
#pragma unroll
        for (int w = 0; w < 8; ++w) s += red[(w * 32 + ct2) * 36 + ci * 4 + j];
        mod[(size_t)(l * 9 + ci) * 6144 + n0 + col] = s + p.ada_b[l * 6144 + n0 + col]; }
    __syncthreads();
}
__device__ __forceinline__ void transpose_item(const float* Wm, int K, int N, bf16_t* WT, LAS float* scr, int item, int lane) {
    const int nblk = N / 64, kb = item / nblk, nb = item % nblk, k0 = 64 * kb, n0 = 64 * nb;
#pragma unroll 8
    for (int i = 0; i < 64; ++i) scr[i * 65 + lane] = Wm[(size_t)(k0 + i) * N + n0 + lane];
    LDS_FENCE();
    const int cc = lane & 7;
#pragma unroll
    for (int j = 0; j < 8; ++j) { const int n = (lane >> 3) + 8 * j; const LAS float* s = scr + (8 * cc) * 65 + n;
        u32x4 o; o.x = pk2(s[0 * 65], s[1 * 65]); o.y = pk2(s[2 * 65], s[3 * 65]); o.z = pk2(s[4 * 65], s[5 * 65]); o.w = pk2(s[6 * 65], s[7 * 65]);
        *(u32x4*)(WT + (size_t)(n0 + n) * K + k0 + 8 * cc) = o; }
    LDS_FENCE();
}
__device__ __forceinline__ void ph0_prep(const Params& p, LAS unsigned char* lds) {
    const int tid = threadIdx.x, lane = tid & 63, wave = tid >> 6, G = gridDim.x, bid = blockIdx.x;
    for (int u = bid; u < 96; u += G) mod_unit(p, lds, u);
    { LAS float* scr = (LAS float*)(lds + wave * 16640);
      const int gw = bid * 8 + wave, NGW = G * 8;
      bf16_t* WinT = (bf16_t*)(p.ws + WS_WIN); bf16_t* WoutT = (bf16_t*)(p.ws + WS_WOUT);
      constexpr int I_IN = 32 * 96, I_OUT = 32 * 32;
      for (int it = gw; it < 2 * I_IN + 2 * I_OUT; it += NGW) {
          int r = it;
          if (r < 2 * I_IN) { const int l = r / I_IN; r -= l * I_IN; transpose_item(p.w_in + (size_t)l * 2048 * 6144, 2048, 6144, WinT + (size_t)l * 6144 * 2048, scr, r, lane); }
          else { r -= 2 * I_IN; const int l = r / I_OUT; r -= l * I_OUT; transpose_item(p.w_out + (size_t)l * 2048 * 2048, 2048, 2048, WoutT + (size_t)l * 2048 * 2048, scr, r, lane); }
      } }
    const int gt = bid * 512 + tid, NT = G * 512;
    { bf16_t* Wg = (bf16_t*)(p.ws + WS_WG);
      for (int idx = gt; idx < 8 * 512 * 128; idx += NT) { const int i = idx & 127, n = (idx >> 7) & 511, h = idx >> 16, g = n >> 7, j = n & 127;
          const float* src = (g & 1) ? p.lru_w_i : p.lru_w_r; const int dir = g >> 1;
          Wg[idx] = f2bf(src[((size_t)(dir * 8 + h) * 128 + i) * 128 + j]); } }
    { float* rc = (float*)(p.ws + WS_ROPE); float* rs = rc + 2048 * 64;
      for (int idx = gt; idx < 2048 * 64; idx += NT) { const int f = idx & 63, t = idx >> 6; const float pos = (f < 32) ? (float)(t >> 6) : (float)(t & 63);
          const float fr = powf(10000.0f, -(float)(f & 31) / 32.0f); const float ang = pos * fr; rc[idx] = cosf(ang); rs[idx] = sinf(ang); } }
    { bf16_t* T1 = (bf16_t*)(p.ws + WS_TAB1);
      for (int i8 = gt; i8 < 512 * 256 / 8; i8 += NT) { const int j = (i8 * 8) >> 8, c0 = (i8 * 8) & 255; float v[8];
#pragma unroll
          for (int e = 0; e < 8; ++e) { const int m = ((j & 255) * (c0 + e)) & 255; const float a = (float)m * (2.0f / 256.0f); v[e] = (j < 256 ? cospif(a) : sinpif(a)) * 0.0625f; }
          u32x4 o; o.x = pk2(v[0], v[1]); o.y = pk2(v[2], v[3]); o.z = pk2(v[4], v[5]); o.w = pk2(v[6], v[7]); *(u32x4*)(T1 + (size_t)i8 * 8) = o; } }
#pragma unroll
    for (int which = 0; which < 2; ++which) {
        const int T = which ? 2048 : 256; const int sh = which ? 12 : 9;
        bf16_t* T2 = (bf16_t*)(p.ws + (which ? WS_TAB2S : WS_TAB2P)); const float sc = which ? 0.02209708691207961f : 0.0625f;
        for (int i8 = gt; i8 < T * 2 * T / 8; i8 += NT) { const int k1 = (i8 * 8) >> sh, c0 = (i8 * 8) & (2 * T - 1); float v[8];
#pragma unroll
            for (int e = 0; e < 8; ++e) { const int col = c0 + e, t = col & (T - 1); const int m = (k1 * t) & (T - 1); const float a = (float)m * (2.0f / (float)T);
                v[e] = (col < T ? cospif(a) : -sinpif(a)) * sc; }
            u32x4 o; o.x = pk2(v[0], v[1]); o.y = pk2(v[2], v[3]); o.z = pk2(v[4], v[5]); o.w = pk2(v[6], v[7]); *(u32x4*)(T2 + (size_t)i8 * 8) = o; }
    }
}

__device__ __forceinline__ void normmod_phase(const Params& p, const float* x0, const float* x1  , int l) {
    const int tid = threadIdx.x, lane = tid & 63, wave = tid >> 6;
    const float* mod = (const float*)(p.ws + WS_MOD) + (size_t)l * 9 * 6144; const float* ng = p.norm_g + l * 2048;
    bf16_t* H = (bf16_t*)(p.ws + WS_H);
    for (int row = blockIdx.x * 8 + wave; row < NTOK; row += gridDim.x * 8) {
        const float* xr = (row < NPR ? x0 : x1) + (size_t)row * D; const int ci = row < NPR ? 8 : ((row - NPR) >> 11);
        f32x4 v[8]; float ss = 0.f;
#pragma unroll
        for (int j = 0; j < 8; ++j) { v[j] = *(const f32x4*)(xr + 4 * lane + 256 * j); ss += (v[j][0] * v[j][0] + v[j][1] * v[j][1]) + (v[j][2] * v[j][2] + v[j][3] * v[j][3]); }
        const float rstd = 1.0f / sqrtf(wave_sum(ss) * (1.0f / 2048.0f) + EPSV);
        const float* sh = mod + (size_t)ci * 6144; const float* sc = sh + 2048;
#pragma unroll
        for (int j = 0; j < 8; ++j) { const int col = 4 * lane + 256 * j; const f32x4 g = *(const f32x4*)(ng + col), s1 = *(const f32x4*)(sc + col), s0 = *(const f32x4*)(sh + col);
            const f32x4 hv = (v[j] * rstd * g) * (1.0f + s1) + s0;
            u32x2 o; o.x = pk2(hv[0], hv[1]); o.y = pk2(hv[2], hv[3]); *(u32x2*)(H + (size_t)row * D + col) = o; }
    }
}

__device__ __forceinline__ int ret_slot(int seq, int h, int dir, int ch) { return seq < 32 ? (((seq * 8 + h) * 2 + dir) * 2 + ch) : (1024 + ((((seq - 32) * 8 + h) * 2 + dir) * 16 + ch)); }
__device__ __forceinline__ void ret_chain(const Params& p, LAS unsigned char* lds, int seq, int h, int dir, int eh) {
    const int tid = threadIdx.x, lane = tid & 63, w = tid >> 6, q = lane >> 4, fr = lane & 15;
    LAS unsigned char* Kt = lds;
    LAS unsigned char* Vt = lds + 34816;
    const bool smp = seq >= 32; const int nch = smp ? 16 : 2; const int rb = smp ? NPR + (seq - 32) * 2048 : seq * 256;
    const bf16_t* Pk = (const bf16_t*)(p.ws + WS_P) + 3 * SLICE_ELEMS; const bf16_t* Pv = (const bf16_t*)(p.ws + WS_P) + 4 * SLICE_ELEMS;
    bf16_t* Sbuf = (bf16_t*)(p.ws + WS_H);
    const float* ropeC = (const float*)(p.ws + WS_ROPE); const float* ropeS = ropeC + 2048 * 64;
    const float lg2 = -log1pf(expf(-p.ret_decay[dir * 8 + h])) * LOG2E;
    const float cd = exp2f(lg2 * 128.0f);
    f32x4 acc[4];
    if (smp) { const float* S0 = p.state_ret + (size_t)(((seq - 32) * 2 + dir) * 8 + h) * 16384;
#pragma unroll
        for (int nb = 0; nb < 4; ++nb)
#pragma unroll
            for (int r = 0; r < 4; ++r) acc[nb][r] = S0[(16 * w + 4 * q + r) * 128 + 64 * eh + 16 * nb + fr]; }
    else {
#pragma unroll
        for (int nb = 0; nb < 4; ++nb) acc[nb] = (f32x4){0.f, 0.f, 0.f, 0.f}; }
    for (int step = 0; step < nch; ++step) {
        const int ch = dir ? nch - 1 - step : step;
        { bf16_t* Sd = Sbuf + (size_t)ret_slot(seq, h, dir, ch) * 16384;
#pragma unroll
          for (int nb = 0; nb < 4; ++nb) { u32x2 v; v.x = pk2(acc[nb][0], acc[nb][1]); v.y = pk2(acc[nb][2], acc[nb][3]);
              *(u32x2*)(Sd + (64 * eh + 16 * nb + fr) * 128 + 16 * w + 4 * q) = v; } }
        { const int tp = tid & 63, fg = tid >> 6, f0 = fg * 8; float o1[2][8], o2[2][8];
#pragma unroll
          for (int tk = 0; tk < 2; ++tk) { const int tl = 2 * tp + tk; const size_t row = (size_t)(rb + ch * 128 + tl);
              const u32x4 a = *(const u32x4*)(Pk + row * 1024 + h * 128 + f0), b = *(const u32x4*)(Pk + row * 1024 + h * 128 + 64 + f0);
              const float x1[8] = {bflo(a.x), bfhi(a.x), bflo(a.y), bfhi(a.y), bflo(a.z), bfhi(a.z), bflo(a.w), bfhi(a.w)};
              const float x2[8] = {bflo(b.x), bfhi(b.x), bflo(b.y), bfhi(b.y), bflo(b.z), bfhi(b.z), bflo(b.w), bfhi(b.w)};
              const float dec = exp2f(lg2 * (float)(dir ? tl : 127 - tl)) * 0.08838834764831845f;
              if (smp) { const int t = ch * 128 + tl; const f32x4 c0 = *(const f32x4*)(ropeC + t * 64 + f0), c1 = *(const f32x4*)(ropeC + t * 64 + f0 + 4), s0 = *(const f32x4*)(ropeS + t * 64 + f0), s1 = *(const f32x4*)(ropeS + t * 64 + f0 + 4);
#pragma unroll
                  for (int j = 0; j < 8; ++j) { const float cs = j < 4 ? c0[j & 3] : c1[j & 3], sn = j < 4 ? s0[j & 3] : s1[j & 3]; o1[tk][j] = (x1[j] * cs - x2[j] * sn) * dec; o2[tk][j] = (x1[j] * sn + x2[j] * cs) * dec; } }
              else {
#pragma unroll
                  for (int j = 0; j < 8; ++j) { o1[tk][j] = x1[j] * dec; o2[tk][j] = x2[j] * dec; } } }
#pragma unroll
          for (int j = 0; j < 8; ++j) { *(LAS unsigned*)(Kt + (f0 + j) * 272 + tp * 4) = pk2(o1[0][j], o1[1][j]); *(LAS unsigned*)(Kt + (64 + f0 + j) * 272 + tp * 4) = pk2(o2[0][j], o2[1][j]); }
          const size_t row0 = (size_t)(rb + ch * 128 + 2 * tp);
          const u32x4 va = *(const u32x4*)(Pv + row0 * 1024 + h * 128 + 64 * eh + f0), vb = *(const u32x4*)(Pv + (row0 + 1) * 1024 + h * 128 + 64 * eh + f0);
          const unsigned wa[4] = {va.x, va.y, va.z, va.w}, wb[4] = {vb.x, vb.y, vb.z, vb.w};
#pragma unroll
          for (int j = 0; j < 4; ++j) { *(LAS unsigned*)(Vt + (f0 + 2 * j) * 272 + tp * 4) = (wa[j] & 0xffffu) | (wb[j] << 16); *(LAS unsigned*)(Vt + (f0 + 2 * j + 1) * 272 + tp * 4) = (wa[j] >> 16) | (wb[j] & 0xffff0000u); } }
        __syncthreads();
#pragma unroll
        for (int nb = 0; nb < 4; ++nb) acc[nb] = acc[nb] * cd;
#pragma unroll
        for (int ks = 0; ks < 4; ++ks) { const bf16x8 A = *(const LAS bf16x8*)(Kt + (16 * w + fr) * 272 + (32 * ks + 8 * q) * 2);
#pragma unroll
            for (int nb = 0; nb < 4; ++nb) { const bf16x8 B = *(const LAS bf16x8*)(Vt + (16 * nb + fr) * 272 + (32 * ks + 8 * q) * 2); acc[nb] = __builtin_amdgcn_mfma_f32_16x16x32_bf16(A, B, acc[nb], 0, 0, 0); } }
        __syncthreads();
    }
    if (!smp) { float* So = p.out + OUT_SRET + (size_t)((seq * 2 + dir) * 8 + h) * 16384;
#pragma unroll
        for (int nb = 0; nb < 4; ++nb)
#pragma unroll
            for (int r = 0; r < 4; ++r) So[(16 * w + 4 * q + r) * 128 + 64 * eh + 16 * nb + fr] = acc[nb][r]; }
}

__device__ __forceinline__ void ret_out_unit(const Params& p, LAS unsigned char* lds, int gch, int h) {
    const int tid = threadIdx.x, lane = tid & 63, w = tid >> 6, q = lane >> 4, fr = lane & 15;
    LAS unsigned char* Qs = lds; LAS unsigned char* Ks = lds + 34816; LAS unsigned char* Vt = lds + 2 * 34816; LAS unsigned char* Pw = lds + 3 * 34816 + w * 4352;
    const bool smp = gch >= 64; const int seq = smp ? 32 + ((gch - 64) >> 4) : (gch >> 1); const int ch = smp ? ((gch - 64) & 15) : (gch & 1);
    const size_t row0 = (size_t)gch * 128;
    const bf16_t* Pq = (const bf16_t*)(p.ws + WS_P) + 2 * SLICE_ELEMS; const bf16_t* Pk = Pq + SLICE_ELEMS; const bf16_t* Pv = Pk + SLICE_ELEMS; bf16_t* Pg = (bf16_t*)(p.ws + WS_P) + 5 * SLICE_ELEMS;
    const bf16_t* Sbuf = (const bf16_t*)(p.ws + WS_H);
    const float* ropeC = (const float*)(p.ws + WS_ROPE); const float* ropeS = ropeC + 2048 * 64;
    const float lgf = -log1pf(expf(-p.ret_decay[h])) * LOG2E, lgb = -log1pf(expf(-p.ret_decay[8 + h])) * LOG2E;
#pragma unroll
    for (int rep = 0; rep < 2; ++rep) { const int it = tid + 512 * rep, fg = it & 7, tl = it >> 3, f0 = fg * 8; const size_t row = row0 + tl;
#pragma unroll
        for (int which = 0; which < 2; ++which) { const bf16_t* src = which ? Pk : Pq; LAS unsigned char* dst = which ? Ks : Qs; const float scl = which ? 0.08838834764831845f : 1.0f;
            const u32x4 a = *(const u32x4*)(src + row * 1024 + h * 128 + f0), b = *(const u32x4*)(src + row * 1024 + h * 128 + 64 + f0);
            const float x1[8] = {bflo(a.x), bfhi(a.x), bflo(a.y), bfhi(a.y), bflo(a.z), bfhi(a.z), bflo(a.w), bfhi(a.w)};
            const float x2[8] = {bflo(b.x), bfhi(b.x), bflo(b.y), bfhi(b.y), bflo(b.z), bfhi(b.z), bflo(b.w), bfhi(b.w)};
            float o1[8], o2[8];
            if (smp) { const int t = ch * 128 + tl; const f32x4 c0 = *(const f32x4*)(ropeC + t * 64 + f0), c1 = *(const f32x4*)(ropeC + t * 64 + f0 + 4), s0 = *(const f32x4*)(ropeS + t * 64 + f0), s1 = *(const f32x4*)(ropeS + t * 64 + f0 + 4);
#pragma unroll
                for (int j = 0; j < 8; ++j) { const float cs = j < 4 ? c0[j & 3] : c1[j & 3], sn = j < 4 ? s0[j & 3] : s1[j & 3]; o1[j] = (x1[j] * cs - x2[j] * sn) * scl; o2[j] = (x1[j] * sn + x2[j] * cs) * scl; } }
            else {
#pragma unroll
                for (int j = 0; j < 8; ++j) { o1[j] = x1[j] * scl; o2[j] = x2[j] * scl; } }
            u32x4 w1, w2; w1.x = pk2(o1[0], o1[1]); w1.y = pk2(o1[2], o1[3]); w1.z = pk2(o1[4], o1[5]); w1.w = pk2(o1[6], o1[7]);
            w2.x = pk2(o2[0], o2[1]); w2.y = pk2(o2[2], o2[3]); w2.z = pk2(o2[4], o2[5]); w2.w = pk2(o2[6], o2[7]);
            *(LAS u32x4*)(dst + tl * 272 + f0 * 2) = w1; *(LAS u32x4*)(dst + tl * 272 + (64 + f0) * 2) = w2; } }
#pragma unroll
    for (int rep = 0; rep < 2; ++rep) { const int it = tid + 512 * rep, tp = it & 63, eg = it >> 6, e0 = eg * 8; const size_t row = row0 + 2 * tp;
        const u32x4 va = *(const u32x4*)(Pv + row * 1024 + h * 128 + e0), vb = *(const u32x4*)(Pv + (row + 1) * 1024 + h * 128 + e0);
        const unsigned wa[4] = {va.x, va.y, va.z, va.w}, wb[4] = {vb.x, vb.y, vb.z, vb.w};
#pragma unroll
        for (int j = 0; j < 4; ++j) { *(LAS unsigned*)(Vt + (e0 + 2 * j) * 272 + tp * 4) = (wa[j] & 0xffffu) | (wb[j] << 16); *(LAS unsigned*)(Vt + (e0 + 2 * j + 1) * 272 + tp * 4) = (wa[j] >> 16) | (wb[j] & 0xffff0000u); } }
    __syncthreads();
    bf16x8 aQ[4];
#pragma unroll
    for (int ks = 0; ks < 4; ++ks) aQ[ks] = *(const LAS bf16x8*)(Qs + (16 * w + fr) * 272 + (32 * ks + 8 * q) * 2);
#pragma unroll
    for (int nb = 0; nb < 8; ++nb) { f32x4 s = (f32x4){0.f, 0.f, 0.f, 0.f};
#pragma unroll
        for (int ks = 0; ks < 4; ++ks) { const bf16x8 B = *(const LAS bf16x8*)(Ks + (16 * nb + fr) * 272 + (32 * ks + 8 * q) * 2); s = __builtin_amdgcn_mfma_f32_16x16x32_bf16(aQ[ks], B, s, 0, 0, 0); }
#pragma unroll
        for (int r = 0; r < 4; ++r) { const int dlt = (16 * w + 4 * q + r) - (16 * nb + fr);
            const float m = dlt > 0 ? exp2f(lgf * (float)dlt) : (dlt < 0 ? exp2f(lgb * (float)(-dlt)) : 2.0f);
            *(LAS bf16_t*)(Pw + (4 * q + r) * 272 + (16 * nb + fr) * 2) = f2bf(s[r] * m); } }
    LDS_FENCE(); __builtin_amdgcn_wave_barrier();
    f32x4 o[8];
#pragma unroll
    for (int eb = 0; eb < 8; ++eb) o[eb] = (f32x4){0.f, 0.f, 0.f, 0.f};
#pragma unroll
    for (int ks = 0; ks < 4; ++ks) { const bf16x8 A = *(const LAS bf16x8*)(Pw + fr * 272 + (32 * ks + 8 * q) * 2);
#pragma unroll
        for (int eb = 0; eb < 8; ++eb) { const bf16x8 B = *(const LAS bf16x8*)(Vt + (16 * eb + fr) * 272 + (32 * ks + 8 * q) * 2); o[eb] = __builtin_amdgcn_mfma_f32_16x16x32_bf16(A, B, o[eb], 0, 0, 0); } }
#pragma unroll
    for (int dir = 0; dir < 2; ++dir) { const bf16_t* Sd = Sbuf + (size_t)ret_slot(seq, h, dir, ch) * 16384; const float lg = dir ? lgb : lgf;
        float dec[4];
#pragma unroll
        for (int r = 0; r < 4; ++r) { const int tl = 16 * w + 4 * q + r; dec[r] = exp2f(lg * (float)(dir ? 128 - tl : tl + 1)); }
#pragma unroll
        for (int eb = 0; eb < 8; ++eb) { f32x4 s = (f32x4){0.f, 0.f, 0.f, 0.f};
#pragma unroll
            for (int ks = 0; ks < 4; ++ks) { const bf16x8 B = *(const bf16x8*)(Sd + (16 * eb + fr) * 128 + 32 * ks + 8 * q); s = __builtin_amdgcn_mfma_f32_16x16x32_bf16(aQ[ks], B, s, 0, 0, 0); }
#pragma unroll
            for (int r = 0; r < 4; ++r) o[eb][r] += dec[r] * s[r]; } }
    float rstd[4];
#pragma unroll
    for (int r = 0; r < 4; ++r) { float ss = 0.f;
#pragma unroll
        for (int eb = 0; eb < 8; ++eb) ss += o[eb][r] * o[eb][r];
        ss += __shfl_xor(ss, 1); ss += __shfl_xor(ss, 2); ss += __shfl_xor(ss, 4); ss += __shfl_xor(ss, 8);
        rstd[r] = 1.0f / sqrtf(ss * (1.0f / 128.0f) + EPSV); }
    LDS_FENCE(); __builtin_amdgcn_wave_barrier();
#pragma unroll
    for (int eb = 0; eb < 8; ++eb) { const int e = 16 * eb + fr; const float g = p.ret_norm_g[h * 128 + e];
#pragma unroll
        for (int r = 0; r < 4; ++r) { const size_t row = row0 + 16 * w + 4 * q + r; const float gt = bflo((unsigned)Pg[row * 1024 + h * 128 + e]);
            *(LAS bf16_t*)(Pw + (4 * q + r) * 272 + e * 2) = f2bf(o[eb][r] * rstd[r] * g * silu(gt)); } }
    LDS_FENCE(); __builtin_amdgcn_wave_barrier();
#pragma unroll
    for (int it = 0; it < 4; ++it) { const int rr = q + 4 * it; const u32x4 v = *(const LAS u32x4*)(Pw + rr * 272 + fr * 16);
        *(u32x4*)(Pg + (row0 + 16 * w + rr) * 1024 + h * 128 + fr * 8) = v; }
    __syncthreads();
}

template <bool FWD>
__device__ __forceinline__ void tile_scan(float (&a)[4][4], float (&b)[4][4], int q, int lane, float& Atot, float& Btot) {
    float As[4], Bs[4], At[4], Bt[4], Ae[4], Be[4];
#pragma unroll
    for (int mb = 0; mb < 4; ++mb) {
        if (FWD) { float A = a[mb][0], B = b[mb][0];
#pragma unroll
            for (int r = 1; r < 4; ++r) { B = B * a[mb][r] + b[mb][r]; A *= a[mb][r]; } As[mb] = A; Bs[mb] = B; }
        else { float A = a[mb][3], B = b[mb][3];
#pragma unroll
            for (int r = 2; r >= 0; --r) { B = B * a[mb][r] + b[mb][r]; A *= a[mb][r]; } As[mb] = A; Bs[mb] = B; }
    }
    const int n1 = FWD ? lane - 16 : lane + 16, n2 = FWD ? lane - 32 : lane + 32;
    const bool v1 = FWD ? (q >= 1) : (q <= 2), v2 = FWD ? (q >= 2) : (q <= 1);
#pragma unroll
    for (int mb = 0; mb < 4; ++mb) {
        const float A1 = __shfl(As[mb], n1), B1 = __shfl(Bs[mb], n1);
        if (v1) { Bs[mb] = B1 * As[mb] + Bs[mb]; As[mb] = A1 * As[mb]; }
        const float A2 = __shfl(As[mb], n2), B2 = __shfl(Bs[mb], n2);
        if (v2) { Bs[mb] = B2 * As[mb] + Bs[mb]; As[mb] = A2 * As[mb]; }
    }
    const int ntot = FWD ? (lane & 15) + 48 : (lane & 15);
#pragma unroll
    for (int mb = 0; mb < 4; ++mb) { At[mb] = __shfl(As[mb], ntot); Bt[mb] = __shfl(Bs[mb], ntot);
        const float ae = __shfl(As[mb], n1), be = __shfl(Bs[mb], n1); Ae[mb] = v1 ? ae : 1.0f; Be[mb] = v1 ? be : 0.0f; }
    float Ac = 1.0f, Bc = 0.0f;
#pragma unroll
    for (int i = 0; i < 4; ++i) { const int mb = FWD ? i : 3 - i;
        float cum = Ac * Ae[mb], hh = Bc * Ae[mb] + Be[mb];
#pragma unroll
        for (int j = 0; j < 4; ++j) { const int r = FWD ? j : 3 - j; hh = a[mb][r] * hh + b[mb][r]; cum = cum * a[mb][r]; b[mb][r] = hh; a[mb][r] = cum; }
        Bc = Bc * At[mb] + Bt[mb]; Ac = Ac * At[mb]; }
    Atot = Ac; Btot = Bc;
}
__device__ __forceinline__ void lru_pass1_unit(const Params& p, LAS unsigned char* lds, int gt, int h) {
    const int tid = threadIdx.x, lane = tid & 63, w = tid >> 6, q = lane >> 4, fr = lane & 15;
    LAS float* Uf = (LAS float*)lds;
    LAS unsigned char* Ub = lds + 33792;
    LAS unsigned char* Ot = lds + 33792 + 17408;
    const bf16_t* xa = (const bf16_t*)(p.ws + WS_P);
    const int T = gt < 128 ? 256 : 2048, t0 = gt < 128 ? (gt & 3) * 64 : ((gt - 128) & 31) * 64; const size_t row0 = (size_t)gt * 64;
    { const int c2 = tid & 63, tg = tid >> 6, hc = h * 128 + 2 * c2;
      const f32x2 w0 = *(const f32x2*)(p.lru_conv_w + hc), w1 = *(const f32x2*)(p.lru_conv_w + 1024 + hc), w2 = *(const f32x2*)(p.lru_conv_w + 2048 + hc), w3 = *(const f32x2*)(p.lru_conv_w + 3072 + hc), bb = *(const f32x2*)(p.lru_conv_b + hc);
      float x0[11], x1[11];
#pragma unroll
      for (int i = 0; i < 11; ++i) { const int tl = tg * 8 - 2 + i, tt = t0 + tl; unsigned v = 0u; if (tt >= 0 && tt < T) v = *(const unsigned*)(xa + (size_t)((long)row0 + tl) * 1024 + hc); x0[i] = bflo(v); x1[i] = bfhi(v); }
#pragma unroll
      for (int j = 0; j < 8; ++j) { const float u0 = w0[0] * x0[j] + w1[0] * x0[j + 1] + w2[0] * x0[j + 2] + w3[0] * x0[j + 3] + bb[0];
          const float u1 = w0[1] * x1[j] + w1[1] * x1[j + 1] + w2[1] * x1[j + 2] + w3[1] * x1[j + 3] + bb[1]; const int tl = tg * 8 + j;
          *(LAS f32x2*)(Uf + tl * 132 + 2 * c2) = (f32x2){u0, u1}; *(LAS unsigned*)(Ub + tl * 272 + 4 * c2) = pk2(u0, u1); } }
    __syncthreads();
    float ga[4][4][4];
    { bf16x8 aU[4][4];
#pragma unroll
      for (int mb = 0; mb < 4; ++mb)
#pragma unroll
          for (int ks = 0; ks < 4; ++ks) aU[mb][ks] = *(const LAS bf16x8*)(Ub + (16 * mb + fr) * 272 + (32 * ks + 8 * q) * 2);
      const bf16_t* Wg = (const bf16_t*)(p.ws + WS_WG) + (size_t)h * 512 * 128;
#pragma unroll
      for (int g = 0; g < 4; ++g) { bf16x8 bW[4];
#pragma unroll
          for (int ks = 0; ks < 4; ++ks) bW[ks] = *(const bf16x8*)(Wg + (size_t)(g * 128 + 16 * w + fr) * 128 + 32 * ks + 8 * q);
#pragma unroll
          for (int mb = 0; mb < 4; ++mb) { f32x4 s = (f32x4){0.f, 0.f, 0.f, 0.f};
#pragma unroll
              for (int ks = 0; ks < 4; ++ks) s = __builtin_amdgcn_mfma_f32_16x16x32_bf16(aU[mb][ks], bW[ks], s, 0, 0, 0);
              ga[g][mb][0] = s[0]; ga[g][mb][1] = s[1]; ga[g][mb][2] = s[2]; ga[g][mb][3] = s[3]; } } }
    const int hc = h * 128 + 16 * w + fr;
    const float kf = -8.0f * LOG2E * log1pf(expf(-p.lru_lambda[hc])), kb = -8.0f * LOG2E * log1pf(expf(-p.lru_lambda[1024 + hc]));
    const float brf = p.lru_b_r[hc], bif = p.lru_b_i[hc], brb = p.lru_b_r[1024 + hc], bib = p.lru_b_i[1024 + hc];
#pragma unroll
    for (int mb = 0; mb < 4; ++mb)
#pragma unroll
        for (int r = 0; r < 4; ++r) { const float uu = Uf[(16 * mb + 4 * q + r) * 132 + 16 * w + fr];
            const float af = exp2f(kf * sigm(ga[0][mb][r] + brf)), bf_ = sqrtf(fmaxf(1.0f - af * af, 0.0f)) * sigm(ga[1][mb][r] + bif) * uu;
            const float ab = exp2f(kb * sigm(ga[2][mb][r] + brb)), bb_ = sqrtf(fmaxf(1.0f - ab * ab, 0.0f)) * sigm(ga[3][mb][r] + bib) * uu;
            ga[0][mb][r] = af; ga[1][mb][r] = bf_; ga[2][mb][r] = ab; ga[3][mb][r] = bb_; }
    float Af, Bf, Ab, Bb;
    tile_scan<true>(ga[0], ga[1], q, lane, Af, Bf);
    tile_scan<false>(ga[2], ga[3], q, lane, Ab, Bb);
#pragma unroll
    for (int mb = 0; mb < 4; ++mb)
#pragma unroll
        for (int r = 0; r < 4; ++r) { const int off = (16 * mb + 4 * q + r) * 272 + (16 * w + fr) * 2;
            *(LAS bf16_t*)(Ot + off) = f2bf(ga[1][mb][r] + ga[3][mb][r]); *(LAS bf16_t*)(Ot + 17408 + off) = f2bf(ga[0][mb][r]); *(LAS bf16_t*)(Ot + 2 * 17408 + off) = f2bf(ga[2][mb][r]); }
    if (q == 0) { float* carr = (float*)(p.ws + WS_CARR);
        *(f32x2*)(carr + ((size_t)(gt * 2 + 0) * 1024 + hc) * 2) = (f32x2){Af, Bf}; *(f32x2*)(carr + ((size_t)(gt * 2 + 1) * 1024 + hc) * 2) = (f32x2){Ab, Bb}; }
    __syncthreads();
    bf16_t* L = (bf16_t*)p.out;
#pragma unroll
    for (int k = 0; k < 6; ++k) { const int idx = tid + 512 * k, tile = idx >> 10, rem = idx & 1023, row = rem >> 4, chk = rem & 15;
        const u32x4 v = *(const LAS u32x4*)(Ot + tile * 17408 + row * 272 + chk * 16);
        *(u32x4*)(L + (size_t)tile * SLICE_ELEMS + (row0 + row) * 1024 + h * 128 + chk * 8) = v; }
    __syncthreads();
}
__device__ __forceinline__ void lru_pass2_unit(const Params& p, int gt, int half) {
    const int tid = threadIdx.x, c4 = half * 512 + (tid & 127) * 4, rg = tid >> 7;
    const bool prm = gt < 128; const int seq = prm ? (gt >> 2) : 32 + ((gt - 128) >> 5); const int ti = prm ? (gt & 3) : ((gt - 128) & 31); const int nT = prm ? 4 : 32; const int gt0 = gt - ti;
    const float* carr = (const float*)(p.ws + WS_CARR);
    f32x4 hf = (f32x4){0.f, 0.f, 0.f, 0.f}, hb = hf;
    if (!prm) { hf = *(const f32x4*)(p.state_lru + (size_t)((seq - 32) * 2 + 0) * 1024 + c4); hb = *(const f32x4*)(p.state_lru + (size_t)((seq - 32) * 2 + 1) * 1024 + c4); }
    for (int k = 0; k < ti; ++k) { const float* cp = carr + ((size_t)((gt0 + k) * 2 + 0) * 1024 + c4) * 2; const f32x4 c0 = *(const f32x4*)cp, c1 = *(const f32x4*)(cp + 4);
        hf[0] = c0[0] * hf[0] + c0[1]; hf[1] = c0[2] * hf[1] + c0[3]; hf[2] = c1[0] * hf[2] + c1[1]; hf[3] = c1[2] * hf[3] + c1[3]; }
    for (int k = nT - 1; k > ti; --k) { const float* cp = carr + ((size_t)((gt0 + k) * 2 + 1) * 1024 + c4) * 2; const f32x4 c0 = *(const f32x4*)cp, c1 = *(const f32x4*)(cp + 4);
        hb[0] = c0[0] * hb[0] + c0[1]; hb[1] = c0[2] * hb[1] + c0[3]; hb[2] = c1[0] * hb[2] + c1[1]; hb[3] = c1[2] * hb[3] + c1[3]; }
    if (prm && rg == 0) {
        if (ti == nT - 1) { const float* cp = carr + ((size_t)(gt * 2 + 0) * 1024 + c4) * 2; const f32x4 c0 = *(const f32x4*)cp, c1 = *(const f32x4*)(cp + 4);
            *(f32x4*)(p.out + OUT_SLRU + (size_t)(seq * 2 + 0) * 1024 + c4) = (f32x4){c0[0] * hf[0] + c0[1], c0[2] * hf[1] + c0[3], c1[0] * hf[2] + c1[1], c1[2] * hf[3] + c1[3]}; }
        if (ti == 0) { const float* cp = carr + ((size_t)(gt * 2 + 1) * 1024 + c4) * 2; const f32x4 c0 = *(const f32x4*)cp, c1 = *(const f32x4*)(cp + 4);
            *(f32x4*)(p.out + OUT_SLRU + (size_t)(seq * 2 + 1) * 1024 + c4) = (f32x4){c0[0] * hb[0] + c0[1], c0[2] * hb[1] + c0[3], c1[0] * hb[2] + c1[1], c1[2] * hb[3] + c1[3]}; }
    }
    const bf16_t* L = (const bf16_t*)p.out; bf16_t* Pga = (bf16_t*)(p.ws + WS_P) + SLICE_ELEMS;
#pragma unroll 4
    for (int i = 0; i < 16; ++i) { const size_t off = ((size_t)gt * 64 + rg * 16 + i) * 1024 + c4;
        const u32x2 s = *(const u32x2*)(L + off), af = *(const u32x2*)(L + SLICE_ELEMS + off), ab = *(const u32x2*)(L + 2 * SLICE_ELEMS + off), g = *(const u32x2*)(Pga + off);
        const float y0 = (bflo(s.x) + bflo(af.x) * hf[0] + bflo(ab.x) * hb[0]) * silu(bflo(g.x)), y1 = (bfhi(s.x) + bfhi(af.x) * hf[1] + bfhi(ab.x) * hb[1]) * silu(bfhi(g.x));
        const float y2 = (bflo(s.y) + bflo(af.y) * hf[2] + bflo(ab.y) * hb[2]) * silu(bflo(g.y)), y3 = (bfhi(s.y) + bfhi(af.y) * hf[3] + bfhi(ab.y) * hb[3]) * silu(bfhi(g.y));
        u32x2 o; o.x = pk2(y0, y1); o.y = pk2(y2, y3); *(u32x2*)(Pga + off) = o; }
}

__device__ __forceinline__ void sconv_unit(const Params& p, int gt, int half) {
    const int tid = threadIdx.x, c4 = half * 512 + (tid & 127) * 4, rg = tid >> 7;
    const int T = gt < 128 ? 256 : 2048, t0 = (gt < 128 ? (gt & 3) : ((gt - 128) & 31)) * 64;
    const bf16_t* P = (const bf16_t*)(p.ws + WS_P); const bf16_t* Pb = P + 2 * SLICE_ELEMS; const bf16_t* Pc = P + 3 * SLICE_ELEMS; const bf16_t* Px = P + 4 * SLICE_ELEMS; bf16_t* Pg = (bf16_t*)(p.ws + WS_P) + 5 * SLICE_ELEMS;
    const f32x4 w0 = *(const f32x4*)(p.sconv_w + c4), w1 = *(const f32x4*)(p.sconv_w + 1024 + c4), w2 = *(const f32x4*)(p.sconv_w + 2048 + c4);
    const int tl0 = rg * 16;
    f32x4 vprev, vcur, vnext;
    auto loadv = [&](int tl) -> f32x4 { const int tt = t0 + tl; if (tt < 0 || tt >= T) return (f32x4){0.f, 0.f, 0.f, 0.f};
        const size_t off = (size_t)((long)gt * 64 + tl) * 1024 + c4; const u32x2 c = *(const u32x2*)(Pc + off), x = *(const u32x2*)(Px + off);
        return (f32x4){bflo(c.x) * bflo(x.x), bfhi(c.x) * bfhi(x.x), bflo(c.y) * bflo(x.y), bfhi(c.y) * bfhi(x.y)}; };
    vprev = loadv(tl0 - 1); vcur = loadv(tl0);
#pragma unroll 4
    for (int i = 0; i < 16; ++i) { const int tl = tl0 + i; vnext = loadv(tl + 1);
        const size_t off = ((size_t)gt * 64 + tl) * 1024 + c4; const u32x2 b = *(const u32x2*)(Pb + off), g = *(const u32x2*)(Pg + off);
        const f32x4 cv = w0 * vprev + w1 * vcur + w2 * vnext;
        u32x2 o; o.x = pk2(bflo(b.x) * cv[0] * silu(bflo(g.x)), bfhi(b.x) * cv[1] * silu(bfhi(g.x))); o.y = pk2(bflo(b.y) * cv[2] * silu(bflo(g.y)), bfhi(b.y) * cv[3] * silu(bfhi(g.y)));
        *(u32x2*)(Pg + off) = o; vprev = vcur; vcur = vnext; }
}

__device__ __forceinline__ void final_norm_phase(const Params& p) {
    const int tid = threadIdx.x, lane = tid & 63, wave = tid >> 6;
    for (int row = blockIdx.x * 8 + wave; row < NTOK; row += gridDim.x * 8) {
        float* xr = p.out + (size_t)row * D; f32x4 v[8]; float ss = 0.f;
#pragma unroll
        for (int j = 0; j < 8; ++j) { v[j] = *(const f32x4*)(xr + 4 * lane + 256 * j); ss += (v[j][0] * v[j][0] + v[j][1] * v[j][1]) + (v[j][2] * v[j][2] + v[j][3] * v[j][3]); }
        const float rstd = 1.0f / sqrtf(wave_sum(ss) * (1.0f / 2048.0f) + EPSV);
#pragma unroll
        for (int j = 0; j < 8; ++j) { const int col = 4 * lane + 256 * j; const f32x4 g = *(const f32x4*)(p.final_norm_g + col); *(f32x4*)(xr + col) = v[j] * rstd * g; }
    }
}

constexpr int NPH = 12;
__global__ void __launch_bounds__(512, 2) mk_fwd(Params p) {
    extern __shared__ __attribute__((aligned(16))) unsigned char lds_raw[];
    LAS unsigned char* lds = (LAS unsigned char*)lds_raw;
    const int G = gridDim.x, bid = blockIdx.x;
#define IN(k) (p.ph_lo <= (k) && (k) < p.ph_hi)
#define SEAM(k) do { if (IN(k) && IN((k) + 1)) { cg::this_grid().sync(); } } while (0)
    const char* Hb = (const char*)(p.ws + WS_H);
    bf16_t* Pb = (bf16_t*)(p.ws + WS_P);
    const float* mod = (const float*)(p.ws + WS_MOD);

    if (IN(0)) ph0_prep(p, lds);
    SEAM(0);
    if (IN(1)) normmod_phase(p, p.x_prompt, p.x_sample - (size_t)NPR * D, 0);
    SEAM(1);
    if (IN(2)) { pg8::GCfg g{2048, 2048, 32, 1 << 30, 0l}; pg8::SchedInProj S{Hb, (const char*)(p.ws + WS_WIN), G, bid}; pg8::EpiBf16Store E{Pb, 1024};
        pg8::gemm_phase(lds, g, S, E); }
    SEAM(2);
    if (IN(3)) {
        for (int ci = bid; ci < 1280; ci += G) {
            if (ci < 256) { const int eh = ci & 1, dir = (ci >> 1) & 1, h = (ci >> 2) & 7, b = ci >> 5; ret_chain(p, lds, 32 + b, h, dir, eh); }
            else { const int cj = ci - 256; const int eh = cj & 1, dir = (cj >> 1) & 1, h = (cj >> 2) & 7, b = cj >> 5; ret_chain(p, lds, b, h, dir, eh); } }
        for (int u = bid; u < 3072; u += G) lru_pass1_unit(p, lds, u >> 3, u & 7);
    }
    SEAM(3);
    if (IN(4)) {
        for (int u = bid; u < 1536; u += G) ret_out_unit(p, lds, u >> 3, u & 7);
        for (int u = bid; u < 768; u += G) lru_pass2_unit(p, u >> 1, u & 1);
    }
    SEAM(4);
    if (IN(5)) { pg8::GCfg g{1024, 2048, 32, 16, (long)(4 * SLICE_ELEMS * 2) - 2048l}; pg8::SchedOutProj S{(const char*)(Pb + SLICE_ELEMS), (const char*)(p.ws + WS_WOUT), G, bid};
        pg8::EpiResid E{p.x_prompt, p.x_sample - (size_t)NPR * D, p.out, mod + 4096};
        pg8::gemm_phase(lds, g, S, E); }
    SEAM(5);
    if (IN(6)) normmod_phase(p, p.out, p.out, 1);
    SEAM(6);
    if (IN(7)) { pg8::GCfg g{2048, 2048, 32, 1 << 30, 0l}; pg8::SchedInProj S{Hb, (const char*)(p.ws + WS_WIN) + (size_t)6144 * 2048 * 2, G, bid}; pg8::EpiBf16Store E{Pb, 1024};
        pg8::gemm_phase(lds, g, S, E); }
    SEAM(7);
    if (IN(8)) {
        bf16_t* PQT = (bf16_t*)(p.ws + WS_H);
        { pg8::GCfg g{256, 1024, 4, 1 << 30, 0l}; pg8::SchedF1 S{(const char*)(p.ws + WS_TAB1), (const char*)(Pb + (size_t)NPR * 1024), G, bid, 2048, 8, (long)32 * 1024 * 512}; pg8::EpiBf16Store E{PQT, 4096};
          pg8::gemm_phase(lds, g, S, E); }
        { pg8::GCfg g{256, 1024, 4, 1 << 30, 0l}; pg8::SchedF1 S{(const char*)(p.ws + WS_TAB1), (const char*)Pb, G, bid, 256, 32, 0l}; pg8::EpiBf16Store E{PQT, 512};
          pg8::gemm_phase(lds, g, S, E); }
        for (int u = bid; u < 768; u += G) sconv_unit(p, u >> 1, u & 1);
    }
    SEAM(8);
    if (IN(9)) {
        const char* PQT = (const char*)(p.ws + WS_H);
        { pg8::GCfg g{4096, 4096, 64, 1 << 30, 0l}; pg8::SchedF2 S{(const char*)(p.ws + WS_TAB2S), PQT + (size_t)32 * 1024 * 512 * 2, G, bid, 2048, 8, NPR}; pg8::EpiSiluInPlace E{Pb};
          pg8::gemm_phase(lds, g, S, E); }
        { pg8::GCfg g{512, 512, 8, 1 << 30, 0l}; pg8::SchedF2 S{(const char*)(p.ws + WS_TAB2P), PQT, G, bid, 256, 32, 0}; pg8::EpiSiluInPlace E{Pb};
          pg8::gemm_phase(lds, g, S, E); }
    }
    SEAM(9);
    if (IN(10)) { pg8::GCfg g{1024, 2048, 32, 16, (long)(4 * SLICE_ELEMS * 2) - 2048l}; pg8::SchedOutProj S{(const char*)(Pb + SLICE_ELEMS), (const char*)(p.ws + WS_WOUT) + (size_t)2048 * 2048 * 2, G, bid};
        pg8::EpiResid E{p.out, p.out, p.out, mod + 9 * 6144 + 4096};
        pg8::gemm_phase(lds, g, S, E); }
    SEAM(10);
    if (IN(11)) final_norm_phase(p);
#undef IN
#undef SEAM
}

extern "C" void kernel_launch(void* const* d_in, const int* in_sizes, int n_in, void* d_out, int out_size, void* d_ws, size_t ws_size, hipStream_t stream) {
    static int grid = 0;
    if (grid == 0) {
        int dev = 0, cus = 0, per_cu = 0;
        if (n_in != 22 || ws_size < WS_END) { fprintf(stderr, "kernel_launch: unexpected n_in %d / ws_size %zu (need %zu)\n", n_in, ws_size, (size_t)WS_END); grid = -1; return; }
        hipGetDevice(&dev); hipDeviceGetAttribute(&cus, hipDeviceAttributeMultiprocessorCount, dev);
        if (hipFuncSetAttribute((const void*)mk_fwd, hipFuncAttributeMaxDynamicSharedMemorySize, LDS_BYTES) != hipSuccess) { fprintf(stderr, "kernel_launch: hipFuncSetAttribute failed\n"); grid = -1; return; }
        if (hipOccupancyMaxActiveBlocksPerMultiprocessor(&per_cu, (const void*)mk_fwd, 512, LDS_BYTES) != hipSuccess || per_cu < 1) { fprintf(stderr, "kernel_launch: occupancy query says %d blocks per CU\n", per_cu); (void)hipGetLastError(); per_cu = 1; }
        grid = cus;
        (void)per_cu;
    }
    if (grid < 0) return;
    Params p{};
    const float** pp = (const float**)&p;
    for (int i = 0; i < 22; ++i) pp[i] = (const float*)d_in[i];
    p.out = (float*)d_out; p.ws = (unsigned char*)d_ws;
#if MK_PER_PHASE_LAUNCH
    for (int ph = 0; ph < NPH; ++ph) { p.ph_lo = ph; p.ph_hi = ph + 1; hipLaunchKernelGGL(mk_fwd, dim3(grid), dim3(512), LDS_BYTES, stream, p); }
#else
    p.ph_lo = 0; p.ph_hi = NPH;
    void* args[] = {&p};
    hipError_t e = hipLaunchCooperativeKernel((const void*)mk_fwd, dim3(grid), dim3(512), args, LDS_BYTES, stream);
    if (e != hipSuccess) fprintf(stderr, "kernel_launch: cooperative launch failed: %s (grid %d)\n", hipGetErrorString(e), grid);
#endif
}
```

```cpp
#include <hip/hip_runtime.h>
#include <hip/hip_cooperative_groups.h>
#include <cstdio>
namespace cg = cooperative_groups;

#ifndef MK_PER_PHASE_LAUNCH
#define MK_PER_PHASE_LAUNCH 0
#endif

#define LAS __attribute__((address_space(3)))
typedef unsigned short bf16_t;
typedef short bf16x8 __attribute__((ext_vector_type(8)));
typedef float f32x4 __attribute__((ext_vector_type(4)));
typedef float f32x2 __attribute__((ext_vector_type(2)));
typedef unsigned u32x4 __attribute__((ext_vector_type(4)));
typedef unsigned u32x2 __attribute__((ext_vector_type(2)));

constexpr int D = 2048, WB = 1024, NTOK = 24576, NPR = 8192;
constexpr int LDS_BYTES = 147456;
constexpr float EPSV = 1e-6f;
constexpr float LOG2E = 1.4426950408889634f;
constexpr size_t SLICE_ELEMS = (size_t)NTOK * WB;

constexpr size_t WS_CTL = 0;
constexpr size_t WS_MOD = 65536;
constexpr size_t WS_WG = WS_MOD + 524288;
constexpr size_t WS_ROPE = WS_WG + (1u << 20);
constexpr size_t WS_TAB1 = WS_ROPE + (1u << 20);
constexpr size_t WS_TAB2P = WS_TAB1 + (256u << 10);
constexpr size_t WS_TAB2S = WS_TAB2P + (256u << 10);
constexpr size_t WS_CARR = WS_TAB2S + (16u << 20);
constexpr size_t WS_WIN = WS_CARR + (6u << 20);
constexpr size_t WS_WOUT = WS_WIN + (48u << 20);
constexpr size_t WS_P = WS_WOUT + (16u << 20);
constexpr size_t WS_H = WS_P + (288ull << 20);
constexpr size_t WS_END = WS_H + (96ull << 20);
constexpr size_t OUT_SLRU = (size_t)NTOK * D;
constexpr size_t OUT_SRET = OUT_SLRU + 65536;

struct Params {
    const float *x_prompt, *x_sample, *state_lru, *state_ret, *c, *c_ctx, *norm_g, *ada_w, *ada_b, *w_in, *w_out,
        *lru_conv_w, *lru_conv_b, *lru_lambda, *lru_w_r, *lru_b_r, *lru_w_i, *lru_b_i, *ret_decay, *ret_norm_g, *sconv_w, *final_norm_g;
    float* out; unsigned char* ws; int ph_lo, ph_hi;
};

__device__ __forceinline__ unsigned pk2(float lo, float hi) { unsigned r; asm("v_cvt_pk_bf16_f32 %0, %1, %2" : "=v"(r) : "v"(lo), "v"(hi)); return r; }
__device__ __forceinline__ bf16_t f2bf(float f) { return (bf16_t)(pk2(f, 0.f) & 0xffffu); }
__device__ __forceinline__ float bflo(unsigned u) { return __uint_as_float(u << 16); }
__device__ __forceinline__ float bfhi(unsigned u) { return __uint_as_float(u & 0xffff0000u); }
__device__ __forceinline__ float sigm(float x) { return __builtin_amdgcn_rcpf(1.f + __expf(-x)); }
__device__ __forceinline__ float silu(float x) { return x * sigm(x); }
__device__ __forceinline__ float wave_sum(float v) {
#pragma unroll
    for (int o = 1; o < 64; o <<= 1) v += __shfl_xor(v, o);
    return v;
}
#define LDS_FENCE() asm volatile("s_waitcnt lgkmcnt(0)" ::: "memory")

namespace pg8 {
constexpr int BM = 256, BK = 64, HALF = 128, HTB = HALF * BK * 2, STAGE_BYTES = 8 * HTB;
__device__ __forceinline__ int lds_byte(int r, int c) { const int st = (r >> 4) * 2 + (c >> 5), rr = r & 15, cc = c & 31, ob = rr * 64 + cc * 2; return st * 1024 + (ob ^ (((ob >> 9) & 1) << 5)); }
__device__ __forceinline__ void stage_rc(int b, int& R, int& C) { const int st = b / 1024, sb = b % 1024, swz = sb ^ (((sb >> 9) & 1) << 5); R = (st >> 1) * 16 + swz / 64; C = (st & 1) * 32 + (swz % 64) / 2; }
__device__ __forceinline__ int perm32(int rho) { const int n = rho >> 4, i = rho & 15; return 8 * (i >> 2) + 4 * n + (i & 3); }

struct GUnit { const char* A; const char* B; long coff; int aux, aux2; };
struct GCfg { int lda, ldb, nt, ksplit; long ksoff; };

template <class Epi, class Sched>
__device__ __forceinline__ void gemm_phase(LAS unsigned char* lds, const GCfg g, const Sched& S, const Epi& E) {
    const int tid = threadIdx.x, wid = __builtin_amdgcn_readfirstlane(tid >> 6), lane = tid & 63, wr = wid >> 2, wc = wid & 3, fr = lane & 15, fq = lane >> 4;
    const int nt = g.nt;
    unsigned voffA[2], voffB[2];
#pragma unroll
    for (int i = 0; i < 2; ++i) { int R, C; stage_rc(tid * 16 + i * 8192, R, C); const int Rb = Epi::PERM ? ((R & ~31) + perm32(R & 31)) : R;
        voffA[i] = (unsigned)(R * g.lda + C) * 2u; voffB[i] = (unsigned)(Rb * g.ldb + C) * 2u; }
    const size_t kstep = (size_t)(BK * 2);
    const size_t hstepA = (size_t)HALF * g.lda * 2, hstepB = (size_t)HALF * g.ldb * 2;
    const unsigned ldsw = (unsigned)wid * 1024u;
    const int aoff = lds_byte(wr * 64 + fr, fq * 8), boff = lds_byte(wc * 32 + fr, fq * 8);
#define PG8_AKT(base, t) ((base) + (size_t)(t) * kstep + ((t) >= g.ksplit ? g.ksoff : 0l))
#define PG8_SA(b, h) (((b) * 2 + (h)) * HTB)
#define PG8_SB(b, h) ((4 + (b) * 2 + (h)) * HTB)
#define PG8_STAGE(bufoff, gbase, voff) do { _Pragma("unroll") for (int _i = 0; _i < 2; ++_i) \
        __builtin_amdgcn_global_load_lds((const unsigned*)((const char*)(gbase) + (voff)[_i]), (LAS unsigned*)(lds + (bufoff) + ldsw + _i * 8192), 16, 0, 0); } while (0)
#define PG8_LDA(dst, b, h) do { _Pragma("unroll") for (int m = 0; m < 4; ++m) _Pragma("unroll") for (int k = 0; k < 2; ++k) dst[m][k] = *(const LAS bf16x8*)(lds + PG8_SA(b, h) + aoff + m * 2048 + k * 1024); } while (0)
#define PG8_LDB(dst, b, h) do { _Pragma("unroll") for (int n = 0; n < 2; ++n) _Pragma("unroll") for (int k = 0; k < 2; ++k) dst[n][k] = *(const LAS bf16x8*)(lds + PG8_SB(b, h) + boff + n * 2048 + k * 1024); } while (0)
#define PG8_MMA(ai, bj, At, Bt) do { __builtin_amdgcn_s_setprio(1); _Pragma("unroll") for (int m = 0; m < 4; ++m) _Pragma("unroll") for (int n = 0; n < 2; ++n) _Pragma("unroll") for (int k = 0; k < 2; ++k) \
        acc[ai][bj][m][n] = __builtin_amdgcn_mfma_f32_16x16x32_bf16(Bt[n][k], At[m][k], acc[ai][bj][m][n], 0, 0, 0); __builtin_amdgcn_s_setprio(0); } while (0)
#define PG8_WAIT_V(n) asm volatile("s_waitcnt vmcnt(" #n ")" ::: "memory")
#define PG8_WAIT_L(n) asm volatile("s_waitcnt lgkmcnt(" #n ")" ::: "memory")
#define PG8_BAR __builtin_amdgcn_s_barrier()
#define PG8_SCHED __builtin_amdgcn_sched_barrier(0)
    GUnit cur, nxt; int ui = 0;
    if (!S.next(0, cur)) return;
    f32x4 acc[2][2][4][2];
#pragma unroll
    for (int a = 0; a < 2; ++a)
#pragma unroll
        for (int b = 0; b < 2; ++b)
#pragma unroll
            for (int m = 0; m < 4; ++m)
#pragma unroll
                for (int n = 0; n < 2; ++n) acc[a][b][m][n] = (f32x4){0.f, 0.f, 0.f, 0.f};
    bf16x8 At[4][2], B0[2][2], B1[2][2];
    const char* cA = cur.A; const char* cB = cur.B;
    PG8_STAGE(PG8_SB(0, 0), cB, voffB); PG8_STAGE(PG8_SA(0, 0), cA, voffA); PG8_STAGE(PG8_SB(0, 1), cB + hstepB, voffB); PG8_STAGE(PG8_SA(0, 1), cA + hstepA, voffA);
    if (wr == 1) PG8_BAR;
    PG8_WAIT_V(4); PG8_BAR;
    PG8_STAGE(PG8_SB(1, 0), cB + kstep, voffB); PG8_STAGE(PG8_SA(1, 0), cA + kstep, voffA); PG8_STAGE(PG8_SB(1, 1), cB + hstepB + kstep, voffB);
    PG8_WAIT_V(6); PG8_BAR;
    for (;;) {
        const bool has_next = S.next(ui + 1, nxt);
        const char* nA = has_next ? nxt.A : cA; const char* nB = has_next ? nxt.B : cB;
        for (int t = 0; t < nt; t += 2) {
            const bool last = (t == nt - 2);
            const char* a1 = PG8_AKT(cA, t + 1);
            const char* a2 = last ? nA : PG8_AKT(cA, t + 2); const char* b2 = last ? nB : cB + (size_t)(t + 2) * kstep;
            const char* a3 = a2 + kstep; const char* b3 = b2 + kstep;
            PG8_LDB(B0, 0, 0); PG8_SCHED; PG8_LDA(At, 0, 0); PG8_STAGE(PG8_SA(1, 1), a1 + hstepA, voffA);
            PG8_WAIT_L(8); PG8_BAR; PG8_WAIT_L(0); PG8_MMA(0, 0, At, B0); PG8_BAR; PG8_SCHED;
            PG8_LDB(B1, 0, 1); PG8_STAGE(PG8_SB(0, 0), b2, voffB);
            PG8_BAR; PG8_WAIT_L(0); PG8_MMA(0, 1, At, B1); PG8_BAR;
            PG8_LDA(At, 0, 1); PG8_STAGE(PG8_SA(0, 0), a2, voffA);
            PG8_BAR; PG8_WAIT_L(0); PG8_MMA(1, 0, At, B0); PG8_BAR; PG8_SCHED;
            PG8_STAGE(PG8_SB(0, 1), b2 + hstepB, voffB);
            PG8_WAIT_V(6); PG8_BAR; PG8_MMA(1, 1, At, B1); PG8_BAR;
            PG8_LDB(B0, 1, 0); PG8_SCHED; PG8_LDA(At, 1, 0); PG8_STAGE(PG8_SA(0, 1), a2 + hstepA, voffA);
            PG8_WAIT_L(8); PG8_BAR; PG8_WAIT_L(0); PG8_MMA(0, 0, At, B0); PG8_BAR; PG8_SCHED;
            PG8_LDB(B1, 1, 1); PG8_STAGE(PG8_SB(1, 0), b3, voffB);
            PG8_BAR; PG8_WAIT_L(0); PG8_MMA(0, 1, At, B1); PG8_BAR;
            PG8_LDA(At, 1, 1); PG8_STAGE(PG8_SA(1, 0), a3, voffA);
            PG8_BAR; PG8_WAIT_L(0); PG8_MMA(1, 0, At, B0); PG8_BAR; PG8_SCHED;
            PG8_STAGE(PG8_SB(1, 1), b3 + hstepB, voffB);
            PG8_WAIT_V(6); PG8_BAR; PG8_MMA(1, 1, At, B1); PG8_BAR;
        }
        E(acc, cur, wr, wc, fr, fq);
        if (!has_next) break;
#pragma unroll
        for (int a = 0; a < 2; ++a)
#pragma unroll
            for (int b = 0; b < 2; ++b)
#pragma unroll
                for (int m = 0; m < 4; ++m)
#pragma unroll
                    for (int n = 0; n < 2; ++n) acc[a][b][m][n] = (f32x4){0.f, 0.f, 0.f, 0.f};
        cur = nxt; cA = nA; cB = nB; ++ui;
    }
    PG8_WAIT_V(0);
    if (wr == 0) PG8_BAR;
    PG8_BAR;
#undef PG8_AKT
#undef PG8_SA
#undef PG8_SB
#undef PG8_STAGE
#undef PG8_LDA
#undef PG8_LDB
#undef PG8_MMA
#undef PG8_WAIT_V
#undef PG8_WAIT_L
#undef PG8_BAR
#undef PG8_SCHED
}

__device__ __forceinline__ bool mn_order(int i, int G, int c, int nM, int nN, int& pm, int& pn) {
    const int nwg = nM * nN; const long L = (long)i * G + c; if (L >= nwg) return false;
    int wgid = (int)L; { const int q = nwg / 8, r = nwg % 8, xcd = wgid % 8, off = wgid / 8; wgid = (xcd < r ? xcd * (q + 1) : r * (q + 1) + (xcd - r) * q) + off; }
    const int nig = 8 * nN, gid = wgid / nig, fm = gid * 8, gsz = (nM - fm) < 8 ? (nM - fm) : 8;
    pm = fm + ((wgid % nig) % gsz); pn = (wgid % nig) / gsz; return true;
}
struct SchedInProj {
    const char* A; const char* B; int G, c;
    __device__ __forceinline__ bool next(int i, GUnit& u) const { int pm, pn; if (!mn_order(i, G, c, NTOK / 256, 24, pm, pn)) return false;
        u.A = A + (size_t)pm * 256 * 2048 * 2; u.B = B + (size_t)pn * 256 * 2048 * 2; u.coff = (long)((size_t)(pn >> 2) * SLICE_ELEMS + (size_t)pm * 256 * 1024 + (pn & 3) * 256); u.aux = 0; u.aux2 = 0; return true; }
};
struct SchedOutProj {
    const char* A; const char* B; int G, c;
    __device__ __forceinline__ bool next(int i, GUnit& u) const { int pm, pn; if (!mn_order(i, G, c, NTOK / 256, 8, pm, pn)) return false;
        u.A = A + (size_t)pm * 256 * 1024 * 2; u.B = B + (size_t)pn * 256 * 2048 * 2; u.coff = (long)((size_t)pm * 256 * 2048 + pn * 256);
        const int r0 = pm * 256; u.aux = r0 < NPR ? 8 : ((r0 - NPR) >> 11); u.aux2 = r0 >= NPR; return true; }
};
struct SchedF1 {
    const char* Tab1; const char* X0  ; int G, c, T, nb; long pqt0;
    __device__ __forceinline__ bool next(int i, GUnit& u) const { const int ntn = T >> 8; const long L = (long)i * G + c; if (L >= (long)nb * 8 * ntn) return false;
        const int tn = (int)(L % ntn), pm = (int)((L / ntn) & 1), gq = (int)((L / (2 * ntn)) & 3), b = (int)(L / (8 * ntn));
        u.A = Tab1 + (size_t)pm * 256 * 256 * 2; u.B = X0 + ((size_t)(b * T + tn * 256) * 1024 + gq * 256) * 2;
        u.coff = pqt0 + (long)(b * 1024 + gq * 256) * (2 * T) + (long)pm * T + tn * 256; u.aux = 0; u.aux2 = 0; return true; }
};
struct SchedF2 {
    const char* Tab2; const char* PQT0; int G, c, T, nb, rowbase;
    __device__ __forceinline__ bool next(int i, GUnit& u) const { const int nm = T >> 8; const long L = (long)i * G + c; if (L >= (long)nb * 4 * nm) return false;
        const int pm = (int)(L % nm), pn = (int)((L / nm) & 3), b = (int)(L / (4 * nm));
        u.A = Tab2 + (size_t)pm * 256 * (2 * T) * 2; u.B = PQT0 + ((size_t)(b * 1024 + pn * 256) * (2 * T)) * 2;
        u.coff = (long)(SLICE_ELEMS + (size_t)(rowbase + b * T + pm * 256) * 1024 + pn * 256); u.aux = 0; u.aux2 = 0; return true; }
};

struct EpiBf16Store {
    static constexpr bool PERM = true;
    bf16_t* O; int ldc;
    __device__ __forceinline__ void operator()(const f32x4 (&acc)[2][2][4][2], const GUnit& u, int wr, int wc, int fr, int fq) const {
        bf16_t* base = O + u.coff + (size_t)(wr * 64 + fr) * ldc + wc * 32 + 8 * fq;
#pragma unroll
        for (int ai = 0; ai < 2; ++ai)
#pragma unroll
            for (int m = 0; m < 4; ++m) { bf16_t* rowp = base + (size_t)(ai * HALF + m * 16) * ldc;
#pragma unroll
                for (int bj = 0; bj < 2; ++bj) { const f32x4 v0 = acc[ai][bj][m][0], v1 = acc[ai][bj][m][1];
                    u32x4 w; w.x = pk2(v0[0], v0[1]); w.y = pk2(v0[2], v0[3]); w.z = pk2(v1[0], v1[1]); w.w = pk2(v1[2], v1[3]);
                    *(u32x4*)(rowp + bj * HALF) = w; } }
    }
};
struct EpiSiluInPlace {
    static constexpr bool PERM = true;
    bf16_t* O;
    __device__ __forceinline__ void operator()(const f32x4 (&acc)[2][2][4][2], const GUnit& u, int wr, int wc, int fr, int fq) const {
        bf16_t* base = O + u.coff + (size_t)(wr * 64 + fr) * 1024 + wc * 32 + 8 * fq;
#pragma unroll
        for (int ai = 0; ai < 2; ++ai)
#pragma unroll
            for (int m = 0; m < 4; ++m) { bf16_t* rowp = base + (size_t)(ai * HALF + m * 16) * 1024;
#pragma unroll
                for (int bj = 0; bj < 2; ++bj) { const f32x4 v0 = acc[ai][bj][m][0], v1 = acc[ai][bj][m][1];
                    const u32x4 gv = *(const u32x4*)(rowp + bj * HALF);
                    u32x4 w; w.x = pk2(v0[0] * silu(bflo(gv.x)), v0[1] * silu(bfhi(gv.x))); w.y = pk2(v0[2] * silu(bflo(gv.y)), v0[3] * silu(bfhi(gv.y)));
                    w.z = pk2(v1[0] * silu(bflo(gv.z)), v1[1] * silu(bfhi(gv.z))); w.w = pk2(v1[2] * silu(bflo(gv.w)), v1[3] * silu(bfhi(gv.w)));
                    *(u32x4*)(rowp + bj * HALF) = w; } }
    }
};
struct EpiResid {
    static constexpr bool PERM = false;
    const float* xin0; const float* xin1; float* out; const float* gate;
    __device__ __forceinline__ void operator()(const f32x4 (&acc)[2][2][4][2], const GUnit& u, int wr, int wc, int fr, int fq) const {
        const size_t off0 = (size_t)u.coff + (size_t)(wr * 64 + fr) * 2048 + wc * 32 + 4 * fq;
        const int col0 = (int)(u.coff & 2047) + wc * 32 + 4 * fq;
        const float* xb = u.aux2 ? xin1 : xin0; const float* gp = gate + (size_t)u.aux * 6144 + col0;
        f32x4 gv[2][2];
#pragma unroll
        for (int bj = 0; bj < 2; ++bj)
#pragma unroll
            for (int n = 0; n < 2; ++n) gv[bj][n] = *(const f32x4*)(gp + bj * HALF + n * 16);
#pragma unroll
        for (int ai = 0; ai < 2; ++ai)
#pragma unroll
            for (int m = 0; m < 4; ++m) { const size_t off = off0 + (size_t)(ai * HALF + m * 16) * 2048;
#pragma unroll
                for (int bj = 0; bj < 2; ++bj)
#pragma unroll
                    for (int n = 0; n < 2; ++n) { const f32x4 xv = *(const f32x4*)(xb + off + bj * HALF + n * 16);
                        *(f32x4*)(out + off + bj * HALF + n * 16) = xv + gv[bj][n] * acc[ai][bj][m][n]; } }
    }
};
}

__device__ __forceinline__ void mod_unit(const Params& p, LAS unsigned char* lds, int u) {
    const int tid = threadIdx.x, lane = tid & 63, wave = tid >> 6;
    LAS float* scond = (LAS float*)lds;
    for (int i = tid; i < 9 * 2048; i += 512) { const int ci = i >> 11, k = i & 2047; const float v = ci < 8 ? p.c[ci * 2048 + k] : p.c_ctx[k]; scond[i] = silu(v); }
    __syncthreads();
    const int l = u / 48, n0 = (u % 48) * 128, ct = lane & 31, rg = 2 * wave + (lane >> 5);
    const float* Wp = p.ada_w + (size_t)l * 2048 * 6144 + n0 + ct * 4;
    float acc[9][4];
#pragma unroll
    for (int ci = 0; ci < 9; ++ci)
#pragma unroll
        for (int j = 0; j < 4; ++j) acc[ci][j] = 0.f;
#pragma unroll 8
    for (int k = rg; k < 2048; k += 16) {
        const f32x4 w = *(const f32x4*)(Wp + (size_t)k * 6144);
#pragma unroll
        for (int ci = 0; ci < 9; ++ci) { const float s = scond[ci * 2048 + k]; acc[ci][0] += s * w[0]; acc[ci][1] += s * w[1]; acc[ci][2] += s * w[2]; acc[ci][3] += s * w[3]; }
    }
#pragma unroll
    for (int ci = 0; ci < 9; ++ci)
#pragma unroll
        for (int j = 0; j < 4; ++j) acc[ci][j] += __shfl_xor(acc[ci][j], 32);
    __syncthreads();
    LAS float* red = (LAS float*)lds;
    if (lane < 32) {
#pragma unroll
        for (int ci = 0; ci < 9; ++ci)
#pragma unroll
            for (int j = 0; j < 4; ++j) red[(wave * 32 + ct) * 36 + ci * 4 + j] = acc[ci][j];
    }
    __syncthreads();
    float* mod = (float*)(p.ws + WS_MOD);
    for (int o = tid; o < 9 * 128; o += 512) { const int ci = o >> 7, col = o & 127, ct2 = col >> 2, j = col & 3; float s = 0.f;
#pragma unroll
        for (int w = 0; w < 8; ++w) s += red[(w * 32 + ct2) * 36 + ci * 4 + j];
        mod[(size_t)(l * 9 + ci) * 6144 + n0 + col] = s + p.ada_b[l * 6144 + n0 + col]; }
    __syncthreads();
}
__device__ __forceinline__ void transpose_item(const float* Wm, int K, int N, bf16_t* WT, LAS float* scr, int item, int lane) {
    const int nblk = N / 64, kb = item / nblk, nb = item % nblk, k0 = 64 * kb, n0 = 64 * nb;
#pragma unroll 8
    for (int i = 0; i < 64; ++i) scr[i * 65 + lane] = Wm[(size_t)(k0 + i) * N + n0 + lane];
    LDS_FENCE();
    const int cc = lane & 7;
#pragma unroll
    for (int j = 0; j < 8; ++j) { const int n = (lane >> 3) + 8 * j; const LAS float* s = scr + (8 * cc) * 65 + n;
        u32x4 o; o.x = pk2(s[0 * 65], s[1 * 65]); o.y = pk2(s[2 * 65], s[3 * 65]); o.z = pk2(s[4 * 65], s[5 * 65]); o.w = pk2(s[6 * 65], s[7 * 65]);
        *(u32x4*)(WT + (size_t)(n0 + n) * K + k0 + 8 * cc) = o; }
    LDS_FENCE();
}
__device__ __forceinline__ void ph0_prep(const Params& p, LAS unsigned char* lds) {
    const int tid = threadIdx.x, lane = tid & 63, wave = tid >> 6, G = gridDim.x, bid = blockIdx.x;
    for (int u = bid; u < 96; u += G) mod_unit(p, lds, u);
    { LAS float* scr = (LAS float*)(lds + wave * 16640);
      const int gw = bid * 8 + wave, NGW = G * 8;
      bf16_t* WinT = (bf16_t*)(p.ws + WS_WIN); bf16_t* WoutT = (bf16_t*)(p.ws + WS_WOUT);
      constexpr int I_IN = 32 * 96, I_OUT = 32 * 32;
      for (int it = gw; it < 2 * I_IN + 2 * I_OUT; it += NGW) {
          int r = it;
          if (r < 2 * I_IN) { const int l = r / I_IN; r -= l * I_IN; transpose_item(p.w_in + (size_t)l * 2048 * 6144, 2048, 6144, WinT + (size_t)l * 6144 * 2048, scr, r, lane); }
          else { r -= 2 * I_IN; const int l = r / I_OUT; r -= l * I_OUT; transpose_item(p.w_out + (size_t)l * 2048 * 2048, 2048, 2048, WoutT + (size_t)l * 2048 * 2048, scr, r, lane); }
      } }
    const int gt = bid * 512 + tid, NT = G * 512;
    { bf16_t* Wg = (bf16_t*)(p.ws + WS_WG);
      for (int idx = gt; idx < 8 * 512 * 128; idx += NT) { const int i = idx & 127, n = (idx >> 7) & 511, h = idx >> 16, g = n >> 7, j = n & 127;
          const float* src = (g & 1) ? p.lru_w_i : p.lru_w_r; const int dir = g >> 1;
          Wg[idx] = f2bf(src[((size_t)(dir * 8 + h) * 128 + i) * 128 + j]); } }
    { float* rc = (float*)(p.ws + WS_ROPE); float* rs = rc + 2048 * 64;
      for (int idx = gt; idx < 2048 * 64; idx += NT) { const int f = idx & 63, t = idx >> 6; const float pos = (f < 32) ? (float)(t >> 6) : (float)(t & 63);
          const float fr = powf(10000.0f, -(float)(f & 31) / 32.0f); const float ang = pos * fr; rc[idx] = cosf(ang); rs[idx] = sinf(ang); } }
    { bf16_t* T1 = (bf16_t*)(p.ws + WS_TAB1);
      for (int i8 = gt; i8 < 512 * 256 / 8; i8 += NT) { const int j = (i8 * 8) >> 8, c0 = (i8 * 8) & 255; float v[8];
#pragma unroll
          for (int e = 0; e < 8; ++e) { const int m = ((j & 255) * (c0 + e)) & 255; const float a = (float)m * (2.0f / 256.0f); v[e] = (j < 256 ? cospif(a) : sinpif(a)) * 0.0625f; }
          u32x4 o; o.x = pk2(v[0], v[1]); o.y = pk2(v[2], v[3]); o.z = pk2(v[4], v[5]); o.w = pk2(v[6], v[7]); *(u32x4*)(T1 + (size_t)i8 * 8) = o; } }
#pragma unroll
    for (int which = 0; which < 2; ++which) {
        const int T = which ? 2048 : 256; const int sh = which ? 12 : 9;
        bf16_t* T2 = (bf16_t*)(p.ws + (which ? WS_TAB2S : WS_TAB2P)); const float sc = which ? 0.02209708691207961f : 0.0625f;
        for (int i8 = gt; i8 < T * 2 * T / 8; i8 += NT) { const int k1 = (i8 * 8) >> sh, c0 = (i8 * 8) & (2 * T - 1); float v[8];
#pragma unroll
            for (int e = 0; e < 8; ++e) { const int col = c0 + e, t = col & (T - 1); const int m = (k1 * t) & (T - 1); const float a = (float)m * (2.0f / (float)T);
                v[e] = (col < T ? cospif(a) : -sinpif(a)) * sc; }
            u32x4 o; o.x = pk2(v[0], v[1]); o.y = pk2(v[2], v[3]); o.z = pk2(v[4], v[5]); o.w = pk2(v[6], v[7]); *(u32x4*)(T2 + (size_t)i8 * 8) = o; }
    }
}

__device__ __forceinline__ void normmod_phase(const Params& p, const float* x0, const float* x1  , int l) {
    const int tid = threadIdx.x, lane = tid & 63, wave = tid >> 6;
    const float* mod = (const float*)(p.ws + WS_MOD) + (size_t)l * 9 * 6144; const float* ng = p.norm_g + l * 2048;
    bf16_t* H = (bf16_t*)(p.ws + WS_H);
    for (int row = blockIdx.x * 8 + wave; row < NTOK; row += gridDim.x * 8) {
        const float* xr = (row < NPR ? x0 : x1) + (size_t)row * D; const int ci = row < NPR ? 8 : ((row - NPR) >> 11);
        f32x4 v[8]; float ss = 0.f;
#pragma unroll
        for (int j = 0; j < 8; ++j) { v[j] = *(const f32x4*)(xr + 4 * lane + 256 * j); ss += (v[j][0] * v[j][0] + v[j][1] * v[j][1]) + (v[j][2] * v[j][2] + v[j][3] * v[j][3]); }
        const float rstd = 1.0f / sqrtf(wave_sum(ss) * (1.0f / 2048.0f) + EPSV);
        const float* sh = mod + (size_t)ci * 6144; const float* sc = sh + 2048;
#pragma unroll
        for (int j = 0; j < 8; ++j) { const int col = 4 * lane + 256 * j; const f32x4 g = *(const f32x4*)(ng + col), s1 = *(const f32x4*)(sc + col), s0 = *(const f32x4*)(sh + col);
            const f32x4 hv = (v[j] * rstd * g) * (1.0f + s1) + s0;
            u32x2 o; o.x = pk2(hv[0], hv[1]); o.y = pk2(hv[2], hv[3]); *(u32x2*)(H + (size_t)row * D + col) = o; }
    }
}

__device__ __forceinline__ int ret_slot(int seq, int h, int dir, int ch) { return seq < 32 ? (((seq * 8 + h) * 2 + dir) * 2 + ch) : (1024 + ((((seq - 32) * 8 + h) * 2 + dir) * 16 + ch)); }
__device__ __forceinline__ void ret_chain(const Params& p, LAS unsigned char* lds, int seq, int h, int dir, int eh) {
    const int tid = threadIdx.x, lane = tid & 63, w = tid >> 6, q = lane >> 4, fr = lane & 15;
    LAS unsigned char* Kt = lds;
    LAS unsigned char* Vt = lds + 34816;
    const bool smp = seq >= 32; const int nch = smp ? 16 : 2; const int rb = smp ? NPR + (seq - 32) * 2048 : seq * 256;
    const bf16_t* Pk = (const bf16_t*)(p.ws + WS_P) + 3 * SLICE_ELEMS; const bf16_t* Pv = (const bf16_t*)(p.ws + WS_P) + 4 * SLICE_ELEMS;
    bf16_t* Sbuf = (bf16_t*)(p.ws + WS_H);
    const float* ropeC = (const float*)(p.ws + WS_ROPE); const float* ropeS = ropeC + 2048 * 64;
    const float lg2 = -log1pf(expf(-p.ret_decay[dir * 8 + h])) * LOG2E;
    const float cd = exp2f(lg2 * 128.0f);
    f32x4 acc[4];
    if (smp) { const float* S0 = p.state_ret + (size_t)(((seq - 32) * 2 + dir) * 8 + h) * 16384;
#pragma unroll
        for (int nb = 0; nb < 4; ++nb)
#pragma unroll
            for (int r = 0; r < 4; ++r) acc[nb][r] = S0[(16 * w + 4 * q + r) * 128 + 64 * eh + 16 * nb + fr]; }
    else {
#pragma unroll
        for (int nb = 0; nb < 4; ++nb) acc[nb] = (f32x4){0.f, 0.f, 0.f, 0.f}; }
    for (int step = 0; step < nch; ++step) {
        const int ch = dir ? nch - 1 - step : step;
        { bf16_t* Sd = Sbuf + (size_t)ret_slot(seq, h, dir, ch) * 16384;
#pragma unroll
          for (int nb = 0; nb < 4; ++nb) { u32x2 v; v.x = pk2(acc[nb][0], acc[nb][1]); v.y = pk2(acc[nb][2], acc[nb][3]);
              *(u32x2*)(Sd + (64 * eh + 16 * nb + fr) * 128 + 16 * w + 4 * q) = v; } }
        { const int tp = tid & 63, fg = tid >> 6, f0 = fg * 8; float o1[2][8], o2[2][8];
#pragma unroll
          for (int tk = 0; tk < 2; ++tk) { const int tl = 2 * tp + tk; const size_t row = (size_t)(rb + ch * 128 + tl);
              const u32x4 a = *(const u32x4*)(Pk + row * 1024 + h * 128 + f0), b = *(const u32x4*)(Pk + row * 1024 + h * 128 + 64 + f0);
              const float x1[8] = {bflo(a.x), bfhi(a.x), bflo(a.y), bfhi(a.y), bflo(a.z), bfhi(a.z), bflo(a.w), bfhi(a.w)};
              const float x2[8] = {bflo(b.x), bfhi(b.x), bflo(b.y), bfhi(b.y), bflo(b.z), bfhi(b.z), bflo(b.w), bfhi(b.w)};
              const float dec = exp2f(lg2 * (float)(dir ? tl : 127 - tl)) * 0.08838834764831845f;
              if (smp) { const int t = ch * 128 + tl; const f32x4 c0 = *(const f32x4*)(ropeC + t * 64 + f0), c1 = *(const f32x4*)(ropeC + t * 64 + f0 + 4), s0 = *(const f32x4*)(ropeS + t * 64 + f0), s1 = *(const f32x4*)(ropeS + t * 64 + f0 + 4);
#pragma unroll
                  for (int j = 0; j < 8; ++j) { const float cs = j < 4 ? c0[j & 3] : c1[j & 3], sn = j < 4 ? s0[j & 3] : s1[j & 3]; o1[tk][j] = (x1[j] * cs - x2[j] * sn) * dec; o2[tk][j] = (x1[j] * sn + x2[j] * cs) * dec; } }
              else {
#pragma unroll
                  for (int j = 0; j < 8; ++j) { o1[tk][j] = x1[j] * dec; o2[tk][j] = x2[j] * dec; } } }
#pragma unroll
          for (int j = 0; j < 8; ++j) { *(LAS unsigned*)(Kt + (f0 + j) * 272 + tp * 4) = pk2(o1[0][j], o1[1][j]); *(LAS unsigned*)(Kt + (64 + f0 + j) * 272 + tp * 4) = pk2(o2[0][j], o2[1][j]); }
          const size_t row0 = (size_t)(rb + ch * 128 + 2 * tp);
          const u32x4 va = *(const u32x4*)(Pv + row0 * 1024 + h * 128 + 64 * eh + f0), vb = *(const u32x4*)(Pv + (row0 + 1) * 1024 + h * 128 + 64 * eh + f0);
          const unsigned wa[4] = {va.x, va.y, va.z, va.w}, wb[4] = {vb.x, vb.y, vb.z, vb.w};
#pragma unroll
          for (int j = 0; j < 4; ++j) { *(LAS unsigned*)(Vt + (f0 + 2 * j) * 272 + tp * 4) = (wa[j] & 0xffffu) | (wb[j] << 16); *(LAS unsigned*)(Vt + (f0 + 2 * j + 1) * 272 + tp * 4) = (wa[j] >> 16) | (wb[j] & 0xffff0000u); } }
        __syncthreads();
#pragma unroll
        for (int nb = 0; nb < 4; ++nb) acc[nb] = acc[nb] * cd;
#pragma unroll
        for (int ks = 0; ks < 4; ++ks) { const bf16x8 A = *(const LAS bf16x8*)(Kt + (16 * w + fr) * 272 + (32 * ks + 8 * q) * 2);
#pragma unroll
            for (int nb = 0; nb < 4; ++nb) { const bf16x8 B = *(const LAS bf16x8*)(Vt + (16 * nb + fr) * 272 + (32 * ks + 8 * q) * 2); acc[nb] = __builtin_amdgcn_mfma_f32_16x16x32_bf16(A, B, acc[nb], 0, 0, 0); } }
        __syncthreads();
    }
    if (!smp) { float* So = p.out + OUT_SRET + (size_t)((seq * 2 + dir) * 8 + h) * 16384;
#pragma unroll
        for (int nb = 0; nb < 4; ++nb)
#pragma unroll
            for (int r = 0; r < 4; ++r) So[(16 * w + 4 * q + r) * 128 + 64 * eh + 16 * nb + fr] = acc[nb][r]; }
}

__device__ __forceinline__ void ret_out_unit(const Params& p, LAS unsigned char* lds, int gch, int h) {
    const int tid = threadIdx.x, lane = tid & 63, w = tid >> 6, q = lane >> 4, fr = lane & 15;
    LAS unsigned char* Qs = lds; LAS unsigned char* Ks = lds + 34816; LAS unsigned char* Vt = lds + 2 * 34816; LAS unsigned char* Pw = lds + 3 * 34816 + w * 4352;
    const bool smp = gch >= 64; const int seq = smp ? 32 + ((gch - 64) >> 4) : (gch >> 1); const int ch = smp ? ((gch - 64) & 15) : (gch & 1);
    const size_t row0 = (size_t)gch * 128;
    const bf16_t* Pq = (const bf16_t*)(p.ws + WS_P) + 2 * SLICE_ELEMS; const bf16_t* Pk = Pq + SLICE_ELEMS; const bf16_t* Pv = Pk + SLICE_ELEMS; bf16_t* Pg = (bf16_t*)(p.ws + WS_P) + 5 * SLICE_ELEMS;
    const bf16_t* Sbuf = (const bf16_t*)(p.ws + WS_H);
    const float* ropeC = (const float*)(p.ws + WS_ROPE); const float* ropeS = ropeC + 2048 * 64;
    const float lgf = -log1pf(expf(-p.ret_decay[h])) * LOG2E, lgb = -log1pf(expf(-p.ret_decay[8 + h])) * LOG2E;
#pragma unroll
    for (int rep = 0; rep < 2; ++rep) { const int it = tid + 512 * rep, fg = it & 7, tl = it >> 3, f0 = fg * 8; const size_t row = row0 + tl;
#pragma unroll
        for (int which = 0; which < 2; ++which) { const bf16_t* src = which ? Pk : Pq; LAS unsigned char* dst = which ? Ks : Qs; const float scl = which ? 0.08838834764831845f : 1.0f;
            const u32x4 a = *(const u32x4*)(src + row * 1024 + h * 128 + f0), b = *(const u32x4*)(src + row * 1024 + h * 128 + 64 + f0);
            const float x1[8] = {bflo(a.x), bfhi(a.x), bflo(a.y), bfhi(a.y), bflo(a.z), bfhi(a.z), bflo(a.w), bfhi(a.w)};
            const float x2[8] = {bflo(b.x), bfhi(b.x), bflo(b.y), bfhi(b.y), bflo(b.z), bfhi(b.z), bflo(b.w), bfhi(b.w)};
            float o1[8], o2[8];
            if (smp) { const int t = ch * 128 + tl; const f32x4 c0 = *(const f32x4*)(ropeC + t * 64 + f0), c1 = *(const f32x4*)(ropeC + t * 64 + f0 + 4), s0 = *(const f32x4*)(ropeS + t * 64 + f0), s1 = *(const f32x4*)(ropeS + t * 64 + f0 + 4);
#pragma unroll
                for (int j = 0; j < 8; ++j) { const float cs = j < 4 ? c0[j & 3] : c1[j & 3], sn = j < 4 ? s0[j & 3] : s1[j & 3]; o1[j] = (x1[j] * cs - x2[j] * sn) * scl; o2[j] = (x1[j] * sn + x2[j] * cs) * scl; } }
            else {
#pragma unroll
                for (int j = 0; j < 8; ++j) { o1[j] = x1[j] * scl; o2[j] = x2[j] * scl; } }
            u32x4 w1, w2; w1.x = pk2(o1[0], o1[1]); w1.y = pk2(o1[2], o1[3]); w1.z = pk2(o1[4], o1[5]); w1.w = pk2(o1[6], o1[7]);
            w2.x = pk2(o2[0], o2[1]); w2.y = pk2(o2[2], o2[3]); w2.z = pk2(o2[4], o2[5]); w2.w = pk2(o2[6], o2[7]);
            *(LAS u32x4*)(dst + tl * 272 + f0 * 2) = w1; *(LAS u32x4*)(dst + tl * 272 + (64 + f0) * 2) = w2; } }
#pragma unroll
    for (int rep = 0; rep < 2; ++rep) { const int it = tid + 512 * rep, tp = it & 63, eg = it >> 6, e0 = eg * 8; const size_t row = row0 + 2 * tp;
        const u32x4 va = *(const u32x4*)(Pv + row * 1024 + h * 128 + e0), vb = *(const u32x4*)(Pv + (row + 1) * 1024 + h * 128 + e0);
        const unsigned wa[4] = {va.x, va.y, va.z, va.w}, wb[4] = {vb.x, vb.y, vb.z, vb.w};
#pragma unroll
        for (int j = 0; j < 4; ++j) { *(LAS unsigned*)(Vt + (e0 + 2 * j) * 272 + tp * 4) = (wa[j] & 0xffffu) | (wb[j] << 16); *(LAS unsigned*)(Vt + (e0 + 2 * j + 1) * 272 + tp * 4) = (wa[j] >> 16) | (wb[j] & 0xffff0000u); } }
    __syncthreads();
    bf16x8 aQ[4];
#pragma unroll
    for (int ks = 0; ks < 4; ++ks) aQ[ks] = *(const LAS bf16x8*)(Qs + (16 * w + fr) * 272 + (32 * ks + 8 * q) * 2);
#pragma unroll
    for (int nb = 0; nb < 8; ++nb) { f32x4 s = (f32x4){0.f, 0.f, 0.f, 0.f};
#pragma unroll
        for (int ks = 0; ks < 4; ++ks) { const bf16x8 B = *(const LAS bf16x8*)(Ks + (16 * nb + fr) * 272 + (32 * ks + 8 * q) * 2); s = __builtin_amdgcn_mfma_f32_16x16x32_bf16(aQ[ks], B, s, 0, 0, 0); }
#pragma unroll
        for (int r = 0; r < 4; ++r) { const int dlt = (16 * w + 4 * q + r) - (16 * nb + fr);
            const float m = dlt > 0 ? exp2f(lgf * (float)dlt) : (dlt < 0 ? exp2f(lgb * (float)(-dlt)) : 2.0f);
            *(LAS bf16_t*)(Pw + (4 * q + r) * 272 + (16 * nb + fr) * 2) = f2bf(s[r] * m); } }
    LDS_FENCE(); __builtin_amdgcn_wave_barrier();
    f32x4 o[8];
#pragma unroll
    for (int eb = 0; eb < 8; ++eb) o[eb] = (f32x4){0.f, 0.f, 0.f, 0.f};
#pragma unroll
    for (int ks = 0; ks < 4; ++ks) { const bf16x8 A = *(const LAS bf16x8*)(Pw + fr * 272 + (32 * ks + 8 * q) * 2);
#pragma unroll
        for (int eb = 0; eb < 8; ++eb) { const bf16x8 B = *(const LAS bf16x8*)(Vt + (16 * eb + fr) * 272 + (32 * ks + 8 * q) * 2); o[eb] = __builtin_amdgcn_mfma_f32_16x16x32_bf16(A, B, o[eb], 0, 0, 0); } }
#pragma unroll
    for (int dir = 0; dir < 2; ++dir) { const bf16_t* Sd = Sbuf + (size_t)ret_slot(seq, h, dir, ch) * 16384; const float lg = dir ? lgb : lgf;
        float dec[4];
#pragma unroll
        for (int r = 0; r < 4; ++r) { const int tl = 16 * w + 4 * q + r; dec[r] = exp2f(lg * (float)(dir ? 128 - tl : tl + 1)); }
#pragma unroll
        for (int eb = 0; eb < 8; ++eb) { f32x4 s = (f32x4){0.f, 0.f, 0.f, 0.f};
#pragma unroll
            for (int ks = 0; ks < 4; ++ks) { const bf16x8 B = *(const bf16x8*)(Sd + (16 * eb + fr) * 128 + 32 * ks + 8 * q); s = __builtin_amdgcn_mfma_f32_16x16x32_bf16(aQ[ks], B, s, 0, 0, 0); }
#pragma unroll
            for (int r = 0; r < 4; ++r) o[eb][r] += dec[r] * s[r]; } }
    float rstd[4];
#pragma unroll
    for (int r = 0; r < 4; ++r) { float ss = 0.f;
#pragma unroll
        for (int eb = 0; eb < 8; ++eb) ss += o[eb][r] * o[eb][r];
        ss += __shfl_xor(ss, 1); ss += __shfl_xor(ss, 2); ss += __shfl_xor(ss, 4); ss += __shfl_xor(ss, 8);
        rstd[r] = 1.0f / sqrtf(ss * (1.0f / 128.0f) + EPSV); }
    LDS_FENCE(); __builtin_amdgcn_wave_barrier();
#pragma unroll
    for (int eb = 0; eb < 8; ++eb) { const int e = 16 * eb + fr; const float g = p.ret_norm_g[h * 128 + e];
#pragma unroll
        for (int r = 0; r < 4; ++r) { const size_t row = row0 + 16 * w + 4 * q + r; const float gt = bflo((unsigned)Pg[row * 1024 + h * 128 + e]);
            *(LAS bf16_t*)(Pw + (4 * q + r) * 272 + e * 2) = f2bf(o[eb][r] * rstd[r] * g * silu(gt)); } }
    LDS_FENCE(); __builtin_amdgcn_wave_barrier();
#pragma unroll
    for (int it = 0; it < 4; ++it) { const int rr = q + 4 * it; const u32x4 v = *(const LAS u32x4*)(Pw + rr * 272 + fr * 16);
        *(u32x4*)(Pg + (row0 + 16 * w + rr) * 1024 + h * 128 + fr * 8) = v; }
    __syncthreads();
}

template <bool FWD>
__device__ __forceinline__ void tile_scan(float (&a)[4][4], float (&b)[4][4], int q, int lane, float& Atot, float& Btot) {
    float As[4], Bs[4], At[4], Bt[4], Ae[4], Be[4];
#pragma unroll
    for (int mb = 0; mb < 4; ++mb) {
        if (FWD) { float A = a[mb][0], B = b[mb][0];
#pragma unroll
            for (int r = 1; r < 4; ++r) { B = B * a[mb][r] + b[mb][r]; A *= a[mb][r]; } As[mb] = A; Bs[mb] = B; }
        else { float A = a[mb][3], B = b[mb][3];
#pragma unroll
            for (int r = 2; r >= 0; --r) { B = B * a[mb][r] + b[mb][r]; A *= a[mb][r]; } As[mb] = A; Bs[mb] = B; }
    }
    const int n1 = FWD ? lane - 16 : lane + 16, n2 = FWD ? lane - 32 : lane + 32;
    const bool v1 = FWD ? (q >= 1) : (q <= 2), v2 = FWD ? (q >= 2) : (q <= 1);
#pragma unroll
    for (int mb = 0; mb < 4; ++mb) {
        const float A1 = __shfl(As[mb], n1), B1 = __shfl(Bs[mb], n1);
        if (v1) { Bs[mb] = B1 * As[mb] + Bs[mb]; As[mb] = A1 * As[mb]; }
        const float A2 = __shfl(As[mb], n2), B2 = __shfl(Bs[mb], n2);
        if (v2) { Bs[mb] = B2 * As[mb] + Bs[mb]; As[mb] = A2 * As[mb]; }
    }
    const int ntot = FWD ? (lane & 15) + 48 : (lane & 15);
#pragma unroll
    for (int mb = 0; mb < 4; ++mb) { At[mb] = __shfl(As[mb], ntot); Bt[mb] = __shfl(Bs[mb], ntot);
        const float ae = __shfl(As[mb], n1), be = __shfl(Bs[mb], n1); Ae[mb] = v1 ? ae : 1.0f; Be[mb] = v1 ? be : 0.0f; }
    float Ac = 1.0f, Bc = 0.0f;
#pragma unroll
    for (int i = 0; i < 4; ++i) { const int mb = FWD ? i : 3 - i;
        float cum = Ac * Ae[mb], hh = Bc * Ae[mb] + Be[mb];
#pragma unroll
        for (int j = 0; j < 4; ++j) { const int r = FWD ? j : 3 - j; hh = a[mb][r] * hh + b[mb][r]; cum = cum * a[mb][r]; b[mb][r] = hh; a[mb][r] = cum; }
        Bc = Bc * At[mb] + Bt[mb]; Ac = Ac * At[mb]; }
    Atot = Ac; Btot = Bc;
}
__device__ __forceinline__ void lru_pass1_unit(const Params& p, LAS unsigned char* lds, int gt, int h) {
    const int tid = threadIdx.x, lane = tid & 63, w = tid >> 6, q = lane >> 4, fr = lane & 15;
    LAS float* Uf = (LAS float*)lds;
    LAS unsigned char* Ub = lds + 33792;
    LAS unsigned char* Ot = lds + 33792 + 17408;
    const bf16_t* xa = (const bf16_t*)(p.ws + WS_P);
    const int T = gt < 128 ? 256 : 2048, t0 = gt < 128 ? (gt & 3) * 64 : ((gt - 128) & 31) * 64; const size_t row0 = (size_t)gt * 64;
    { const int c2 = tid & 63, tg = tid >> 6, hc = h * 128 + 2 * c2;
      const f32x2 w0 = *(const f32x2*)(p.lru_conv_w + hc), w1 = *(const f32x2*)(p.lru_conv_w + 1024 + hc), w2 = *(const f32x2*)(p.lru_conv_w + 2048 + hc), w3 = *(const f32x2*)(p.lru_conv_w + 3072 + hc), bb = *(const f32x2*)(p.lru_conv_b + hc);
      float x0[11], x1[11];
#pragma unroll
      for (int i = 0; i < 11; ++i) { const int tl = tg * 8 - 2 + i, tt = t0 + tl; unsigned v = 0u; if (tt >= 0 && tt < T) v = *(const unsigned*)(xa + (size_t)((long)row0 + tl) * 1024 + hc); x0[i] = bflo(v); x1[i] = bfhi(v); }
#pragma unroll
      for (int j = 0; j < 8; ++j) { const float u0 = w0[0] * x0[j] + w1[0] * x0[j + 1] + w2[0] * x0[j + 2] + w3[0] * x0[j + 3] + bb[0];
          const float u1 = w0[1] * x1[j] + w1[1] * x1[j + 1] + w2[1] * x1[j + 2] + w3[1] * x1[j + 3] + bb[1]; const int tl = tg * 8 + j;
          *(LAS f32x2*)(Uf + tl * 132 + 2 * c2) = (f32x2){u0, u1}; *(LAS unsigned*)(Ub + tl * 272 + 4 * c2) = pk2(u0, u1); } }
    __syncthreads();
    float ga[4][4][4];
    { bf16x8 aU[4][4];
#pragma unroll
      for (int mb = 0; mb < 4; ++mb)
#pragma unroll
          for (int ks = 0; ks < 4; ++ks) aU[mb][ks] = *(const LAS bf16x8*)(Ub + (16 * mb + fr) * 272 + (32 * ks + 8 * q) * 2);
      const bf16_t* Wg = (const bf16_t*)(p.ws + WS_WG) + (size_t)h * 512 * 128;
#pragma unroll
      for (int g = 0; g < 4; ++g) { bf16x8 bW[4];
#pragma unroll
          for (int ks = 0; ks < 4; ++ks) bW[ks] = *(const bf16x8*)(Wg + (size_t)(g * 128 + 16 * w + fr) * 128 + 32 * ks + 8 * q);
#pragma unroll
          for (int mb = 0; mb < 4; ++mb) { f32x4 s = (f32x4){0.f, 0.f, 0.f, 0.f};
#pragma unroll
              for (int ks = 0; ks < 4; ++ks) s = __builtin_amdgcn_mfma_f32_16x16x32_bf16(aU[mb][ks], bW[ks], s, 0, 0, 0);
              ga[g][mb][0] = s[0]; ga[g][mb][1] = s[1]; ga[g][mb][2] = s[2]; ga[g][mb][3] = s[3]; } } }
    const int hc = h * 128 + 16 * w + fr;
    const float kf = -8.0f * LOG2E * log1pf(expf(-p.lru_lambda[hc])), kb = -8.0f * LOG2E * log1pf(expf(-p.lru_lambda[1024 + hc]));
    const float brf = p.lru_b_r[hc], bif = p.lru_b_i[hc], brb = p.lru_b_r[1024 + hc], bib = p.lru_b_i[1024 + hc];
#pragma unroll
    for (int mb = 0; mb < 4; ++mb)
#pragma unroll
        for (int r = 0; r < 4; ++r) { const float uu = Uf[(16 * mb + 4 * q + r) * 132 + 16 * w + fr];
            const float af = exp2f(kf * sigm(ga[0][mb][r] + brf)), bf_ = sqrtf(fmaxf(1.0f - af * af, 0.0f)) * sigm(ga[1][mb][r] + bif) * uu;
            const float ab = exp2f(kb * sigm(ga[2][mb][r] + brb)), bb_ = sqrtf(fmaxf(1.0f - ab * ab, 0.0f)) * sigm(ga[3][mb][r] + bib) * uu;
            ga[0][mb][r] = af; ga[1][mb][r] = bf_; ga[2][mb][r] = ab; ga[3][mb][r] = bb_; }
    float Af, Bf, Ab, Bb;
    tile_scan<true>(ga[0], ga[1], q, lane, Af, Bf);
    tile_scan<false>(ga[2], ga[3], q, lane, Ab, Bb);
#pragma unroll
    for (int mb = 0; mb < 4; ++mb)
#pragma unroll
        for (int r = 0; r < 4; ++r) { const int off = (16 * mb + 4 * q + r) * 272 + (16 * w + fr) * 2;
            *(LAS bf16_t*)(Ot + off) = f2bf(ga[1][mb][r] + ga[3][mb][r]); *(LAS bf16_t*)(Ot + 17408 + off) = f2bf(ga[0][mb][r]); *(LAS bf16_t*)(Ot + 2 * 17408 + off) = f2bf(ga[2][mb][r]); }
    if (q == 0) { float* carr = (float*)(p.ws + WS_CARR);
        *(f32x2*)(carr + ((size_t)(gt * 2 + 0) * 1024 + hc) * 2) = (f32x2){Af, Bf}; *(f32x2*)(carr + ((size_t)(gt * 2 + 1) * 1024 + hc) * 2) = (f32x2){Ab, Bb}; }
    __syncthreads();
    bf16_t* L = (bf16_t*)p.out;
#pragma unroll
    for (int k = 0; k < 6; ++k) { const int idx = tid + 512 * k, tile = idx >> 10, rem = idx & 1023, row = rem >> 4, chk = rem & 15;
        const u32x4 v = *(const LAS u32x4*)(Ot + tile * 17408 + row * 272 + chk * 16);
        *(u32x4*)(L + (size_t)tile * SLICE_ELEMS + (row0 + row) * 1024 + h * 128 + chk * 8) = v; }
    __syncthreads();
}
__device__ __forceinline__ void lru_pass2_unit(const Params& p, int gt, int half) {
    const int tid = threadIdx.x, c4 = half * 512 + (tid & 127) * 4, rg = tid >> 7;
    const bool prm = gt < 128; const int seq = prm ? (gt >> 2) : 32 + ((gt - 128) >> 5); const int ti = prm ? (gt & 3) : ((gt - 128) & 31); const int nT = prm ? 4 : 32; const int gt0 = gt - ti;
    const float* carr = (const float*)(p.ws + WS_CARR);
    f32x4 hf = (f32x4){0.f, 0.f, 0.f, 0.f}, hb = hf;
    if (!prm) { hf = *(const f32x4*)(p.state_lru + (size_t)((seq - 32) * 2 + 0) * 1024 + c4); hb = *(const f32x4*)(p.state_lru + (size_t)((seq - 32) * 2 + 1) * 1024 + c4); }
    for (int k = 0; k < ti; ++k) { const float* cp = carr + ((size_t)((gt0 + k) * 2 + 0) * 1024 + c4) * 2; const f32x4 c0 = *(const f32x4*)cp, c1 = *(const f32x4*)(cp + 4);
        hf[0] = c0[0] * hf[0] + c0[1]; hf[1] = c0[2] * hf[1] + c0[3]; hf[2] = c1[0] * hf[2] + c1[1]; hf[3] = c1[2] * hf[3] + c1[3]; }
    for (int k = nT - 1; k > ti; --k) { const float* cp = carr + ((size_t)((gt0 + k) * 2 + 1) * 1024 + c4) * 2; const f32x4 c0 = *(const f32x4*)cp, c1 = *(const f32x4*)(cp + 4);
        hb[0] = c0[0] * hb[0] + c0[1]; hb[1] = c0[2] * hb[1] + c0[3]; hb[2] = c1[0] * hb[2] + c1[1]; hb[3] = c1[2] * hb[3] + c1[3]; }
    if (prm && rg == 0) {
        if (ti == nT - 1) { const float* cp = carr + ((size_t)(gt * 2 + 0) * 1024 + c4) * 2; const f32x4 c0 = *(const f32x4*)cp, c1 = *(const f32x4*)(cp + 4);
            *(f32x4*)(p.out + OUT_SLRU + (size_t)(seq * 2 + 0) * 1024 + c4) = (f32x4){c0[0] * hf[0] + c0[1], c0[2] * hf[1] + c0[3], c1[0] * hf[2] + c1[1], c1[2] * hf[3] + c1[3]}; }
        if (ti == 0) { const float* cp = carr + ((size_t)(gt * 2 + 1) * 1024 + c4) * 2; const f32x4 c0 = *(const f32x4*)cp, c1 = *(const f32x4*)(cp + 4);
            *(f32x4*)(p.out + OUT_SLRU + (size_t)(seq * 2 + 1) * 1024 + c4) = (f32x4){c0[0] * hb[0] + c0[1], c0[2] * hb[1] + c0[3], c1[0] * hb[2] + c1[1], c1[2] * hb[3] + c1[3]}; }
    }
    const bf16_t* L = (const bf16_t*)p.out; bf16_t* Pga = (bf16_t*)(p.ws + WS_P) + SLICE_ELEMS;
#pragma unroll 4
    for (int i = 0; i < 16; ++i) { const size_t off = ((size_t)gt * 64 + rg * 16 + i) * 1024 + c4;
        const u32x2 s = *(const u32x2*)(L + off), af = *(const u32x2*)(L + SLICE_ELEMS + off), ab = *(const u32x2*)(L + 2 * SLICE_ELEMS + off), g = *(const u32x2*)(Pga + off);
        const float y0 = (bflo(s.x) + bflo(af.x) * hf[0] + bflo(ab.x) * hb[0]) * silu(bflo(g.x)), y1 = (bfhi(s.x) + bfhi(af.x) * hf[1] + bfhi(ab.x) * hb[1]) * silu(bfhi(g.x));
        const float y2 = (bflo(s.y) + bflo(af.y) * hf[2] + bflo(ab.y) * hb[2]) * silu(bflo(g.y)), y3 = (bfhi(s.y) + bfhi(af.y) * hf[3] + bfhi(ab.y) * hb[3]) * silu(bfhi(g.y));
        u32x2 o; o.x = pk2(y0, y1); o.y = pk2(y2, y3); *(u32x2*)(Pga + off) = o; }
}

__device__ __forceinline__ void sconv_unit(const Params& p, int gt, int half) {
    const int tid = threadIdx.x, c4 = half * 512 + (tid & 127) * 4, rg = tid >> 7;
    const int T = gt < 128 ? 256 : 2048, t0 = (gt < 128 ? (gt & 3) : ((gt - 128) & 31)) * 64;
    const bf16_t* P = (const bf16_t*)(p.ws + WS_P); const bf16_t* Pb = P + 2 * SLICE_ELEMS; const bf16_t* Pc = P + 3 * SLICE_ELEMS; const bf16_t* Px = P + 4 * SLICE_ELEMS; bf16_t* Pg = (bf16_t*)(p.ws + WS_P) + 5 * SLICE_ELEMS;
    const f32x4 w0 = *(const f32x4*)(p.sconv_w + c4), w1 = *(const f32x4*)(p.sconv_w + 1024 + c4), w2 = *(const f32x4*)(p.sconv_w + 2048 + c4);
    const int tl0 = rg * 16;
    f32x4 vprev, vcur, vnext;
    auto loadv = [&](int tl) -> f32x4 { const int tt = t0 + tl; if (tt < 0 || tt >= T) return (f32x4){0.f, 0.f, 0.f, 0.f};
        const size_t off = (size_t)((long)gt * 64 + tl) * 1024 + c4; const u32x2 c = *(const u32x2*)(Pc + off), x = *(const u32x2*)(Px + off);
        return (f32x4){bflo(c.x) * bflo(x.x), bfhi(c.x) * bfhi(x.x), bflo(c.y) * bflo(x.y), bfhi(c.y) * bfhi(x.y)}; };
    vprev = loadv(tl0 - 1); vcur = loadv(tl0);
#pragma unroll 4
    for (int i = 0; i < 16; ++i) { const int tl = tl0 + i; vnext = loadv(tl + 1);
        const size_t off = ((size_t)gt * 64 + tl) * 1024 + c4; const u32x2 b = *(const u32x2*)(Pb + off), g = *(const u32x2*)(Pg + off);
        const f32x4 cv = w0 * vprev + w1 * vcur + w2 * vnext;
        u32x2 o; o.x = pk2(bflo(b.x) * cv[0] * silu(bflo(g.x)), bfhi(b.x) * cv[1] * silu(bfhi(g.x))); o.y = pk2(bflo(b.y) * cv[2] * silu(bflo(g.y)), bfhi(b.y) * cv[3] * silu(bfhi(g.y)));
        *(u32x2*)(Pg + off) = o; vprev = vcur; vcur = vnext; }
}

__device__ __forceinline__ void final_norm_phase(const Params& p) {
    const int tid = threadIdx.x, lane = tid & 63, wave = tid >> 6;
    for (int row = blockIdx.x * 8 + wave; row < NTOK; row += gridDim.x * 8) {
        float* xr = p.out + (size_t)row * D; f32x4 v[8]; float ss = 0.f;
#pragma unroll
        for (int j = 0; j < 8; ++j) { v[j] = *(const f32x4*)(xr + 4 * lane + 256 * j); ss += (v[j][0] * v[j][0] + v[j][1] * v[j][1]) + (v[j][2] * v[j][2] + v[j][3] * v[j][3]); }
        const float rstd = 1.0f / sqrtf(wave_sum(ss) * (1.0f / 2048.0f) + EPSV);
#pragma unroll
        for (int j = 0; j < 8; ++j) { const int col = 4 * lane + 256 * j; const f32x4 g = *(const f32x4*)(p.final_norm_g + col); *(f32x4*)(xr + col) = v[j] * rstd * g; }
    }
}


#define XB_TMO      128
#define XB_XCNT(j)  (256  + 64 * (j))
#define XB_XSUB(j)  (1280 + 64 * (j))
#define XB_XGEN(j)  (2304 + 64 * (j))
#define XB_TOP      3328
#define XB_TOPGEN   3392
#define XCD_BAR_WORDS 3456
#define XB_SPIN_CAP (1u << 18)
__device__ __forceinline__ unsigned xb_ld(unsigned* p)              { return __hip_atomic_load(p, __ATOMIC_RELAXED, __HIP_MEMORY_SCOPE_AGENT); }
__device__ __forceinline__ unsigned xb_add(unsigned* p, unsigned v) { return __hip_atomic_fetch_add(p, v, __ATOMIC_RELAXED, __HIP_MEMORY_SCOPE_AGENT); }
__device__ __forceinline__ unsigned xb_xcc_id() { return (unsigned)__builtin_amdgcn_s_getreg((3 << 11) | 20) & 0xFu; }
#define XB_SPIN(cond, bar) do { unsigned _sp = 0; while (cond) { __builtin_amdgcn_s_sleep(1); \
    if ((++_sp & 255u) == 0u) { if (xb_ld(&(bar)[XB_TMO])) break; if (_sp > XB_SPIN_CAP) { atomicAdd(&(bar)[XB_TMO], 1u); break; } } } } while (0)
struct XcdBarrier { unsigned* bar; unsigned x; volatile LAS unsigned* st; };
__device__ __forceinline__ XcdBarrier xcd_barrier_post(unsigned* bar, volatile LAS unsigned* st) {
    XcdBarrier b; b.bar = bar; b.x = xb_xcc_id(); b.st = st;
    if (threadIdx.x == 0) (void)xb_add(&bar[XB_XCNT(b.x)], 1u);
    return b;
}
__device__ __forceinline__ void xcd_barrier_complete(unsigned* bar, unsigned x, unsigned& nloc, unsigned& nx) {
    const unsigned G = gridDim.x * gridDim.y * gridDim.z;
    unsigned sum, cnt, mine, sp = 0u;
    for (;;) {
        sum = 0u; cnt = 0u; mine = 0u;
#pragma unroll
        for (unsigned j = 0; j < 16; ++j) { const unsigned c = xb_ld(&bar[XB_XCNT(j)]); sum += c; cnt += (c > 0u) ? 1u : 0u; mine = (j == x) ? c : mine; }
        if (sum == G) break;
        __builtin_amdgcn_s_sleep(1);
        if ((++sp & 255u) == 0u) { if (xb_ld(&bar[XB_TMO])) break; if (sp > XB_SPIN_CAP) { atomicAdd(&bar[XB_TMO], 1u); break; } }
    }
    nloc = mine > 0u ? mine : 1u; nx = cnt > 0u ? cnt : 1u;
}
__device__ __forceinline__ void xcd_barrier(const XcdBarrier& b) {
    asm volatile("s_waitcnt vmcnt(0)" ::: "memory");
    __syncthreads();
    if (threadIdx.x == 0) {
        unsigned* bar = b.bar;
        __builtin_amdgcn_s_waitcnt(0);
        unsigned nloc = b.st[0], nx = b.st[1];
        if (nloc == 0u) { xcd_barrier_complete(bar, b.x, nloc, nx); b.st[0] = nloc; b.st[1] = nx; }
        const unsigned old = xb_add(&bar[XB_XSUB(b.x)], 1u);
        const unsigned gen = old / nloc;
        if (old + 1u == (gen + 1u) * nloc) {
            __builtin_amdgcn_fence(__ATOMIC_RELEASE, "agent");
            asm volatile("s_waitcnt vmcnt(0)" ::: "memory");
            const unsigned og = xb_add(&bar[XB_TOP], 1u);
            const unsigned tg = og / nx;
            if (og + 1u == (tg + 1u) * nx) xb_add(&bar[XB_TOPGEN], 1u);
            else XB_SPIN(xb_ld(&bar[XB_TOPGEN]) == tg, bar);
            __builtin_amdgcn_fence(__ATOMIC_ACQUIRE, "agent");
            xb_add(&bar[XB_XGEN(b.x)], 1u);
            asm volatile("s_waitcnt vmcnt(0)" ::: "memory");
        } else {
            XB_SPIN(xb_ld(&bar[XB_XGEN(b.x)]) == gen, bar);
            __builtin_amdgcn_fence(__ATOMIC_ACQUIRE, "agent");
            asm volatile("s_waitcnt vmcnt(0)" ::: "memory");
        }
    }
    __syncthreads();
}

constexpr int NPH = 12;
__global__ void __launch_bounds__(512, 2) mk_fwd(Params p) {
    extern __shared__ __attribute__((aligned(16))) unsigned char lds_raw[];
    LAS unsigned char* lds = (LAS unsigned char*)lds_raw;
    const int G = gridDim.x, bid = blockIdx.x;
#define IN(k) (p.ph_lo <= (k) && (k) < p.ph_hi)
    volatile LAS unsigned* MISC = (volatile LAS unsigned*)(lds + LDS_BYTES - 16);
    if (threadIdx.x < 4) MISC[threadIdx.x] = 0u;
    __syncthreads();
    const XcdBarrier xbar = xcd_barrier_post((unsigned*)(p.ws + WS_CTL), MISC);
#define SEAM(k) do { if (IN(k) && IN((k) + 1)) { if ((k) == 0) cg::this_grid().sync(); else xcd_barrier(xbar); } } while (0)
    const char* Hb = (const char*)(p.ws + WS_H);
    bf16_t* Pb = (bf16_t*)(p.ws + WS_P);
    const float* mod = (const float*)(p.ws + WS_MOD);

    if (IN(0)) ph0_prep(p, lds);
    SEAM(0);
    if (IN(1)) normmod_phase(p, p.x_prompt, p.x_sample - (size_t)NPR * D, 0);
    SEAM(1);
    if (IN(2)) { pg8::GCfg g{2048, 2048, 32, 1 << 30, 0l}; pg8::SchedInProj S{Hb, (const char*)(p.ws + WS_WIN), G, bid}; pg8::EpiBf16Store E{Pb, 1024};
        pg8::gemm_phase(lds, g, S, E); }
    SEAM(2);
    if (IN(3)) {
        for (int ci = bid; ci < 1280; ci += G) {
            if (ci < 256) { const int eh = ci & 1, dir = (ci >> 1) & 1, h = (ci >> 2) & 7, b = ci >> 5; ret_chain(p, lds, 32 + b, h, dir, eh); }
            else { const int cj = ci - 256; const int eh = cj & 1, dir = (cj >> 1) & 1, h = (cj >> 2) & 7, b = cj >> 5; ret_chain(p, lds, b, h, dir, eh); } }
        for (int u = bid; u < 3072; u += G) lru_pass1_unit(p, lds, u >> 3, u & 7);
    }
    SEAM(3);
    if (IN(4)) {
        for (int u = bid; u < 1536; u += G) ret_out_unit(p, lds, u >> 3, u & 7);
        for (int u = bid; u < 768; u += G) lru_pass2_unit(p, u >> 1, u & 1);
    }
    SEAM(4);
    if (IN(5)) { pg8::GCfg g{1024, 2048, 32, 16, (long)(4 * SLICE_ELEMS * 2) - 2048l}; pg8::SchedOutProj S{(const char*)(Pb + SLICE_ELEMS), (const char*)(p.ws + WS_WOUT), G, bid};
        pg8::EpiResid E{p.x_prompt, p.x_sample - (size_t)NPR * D, p.out, mod + 4096};
        pg8::gemm_phase(lds, g, S, E); }
    SEAM(5);
    if (IN(6)) normmod_phase(p, p.out, p.out, 1);
    SEAM(6);
    if (IN(7)) { pg8::GCfg g{2048, 2048, 32, 1 << 30, 0l}; pg8::SchedInProj S{Hb, (const char*)(p.ws + WS_WIN) + (size_t)6144 * 2048 * 2, G, bid}; pg8::EpiBf16Store E{Pb, 1024};
        pg8::gemm_phase(lds, g, S, E); }
    SEAM(7);
    if (IN(8)) {
        bf16_t* PQT = (bf16_t*)(p.ws + WS_H);
        { pg8::GCfg g{256, 1024, 4, 1 << 30, 0l}; pg8::SchedF1 S{(const char*)(p.ws + WS_TAB1), (const char*)(Pb + (size_t)NPR * 1024), G, bid, 2048, 8, (long)32 * 1024 * 512}; pg8::EpiBf16Store E{PQT, 4096};
          pg8::gemm_phase(lds, g, S, E); }
        { pg8::GCfg g{256, 1024, 4, 1 << 30, 0l}; pg8::SchedF1 S{(const char*)(p.ws + WS_TAB1), (const char*)Pb, G, bid, 256, 32, 0l}; pg8::EpiBf16Store E{PQT, 512};
          pg8::gemm_phase(lds, g, S, E); }
        for (int u = bid; u < 768; u += G) sconv_unit(p, u >> 1, u & 1);
    }
    SEAM(8);
    if (IN(9)) {
        const char* PQT = (const char*)(p.ws + WS_H);
        { pg8::GCfg g{4096, 4096, 64, 1 << 30, 0l}; pg8::SchedF2 S{(const char*)(p.ws + WS_TAB2S), PQT + (size_t)32 * 1024 * 512 * 2, G, bid, 2048, 8, NPR}; pg8::EpiSiluInPlace E{Pb};
          pg8::gemm_phase(lds, g, S, E); }
        { pg8::GCfg g{512, 512, 8, 1 << 30, 0l}; pg8::SchedF2 S{(const char*)(p.ws + WS_TAB2P), PQT, G, bid, 256, 32, 0}; pg8::EpiSiluInPlace E{Pb};
          pg8::gemm_phase(lds, g, S, E); }
    }
    SEAM(9);
    if (IN(10)) { pg8::GCfg g{1024, 2048, 32, 16, (long)(4 * SLICE_ELEMS * 2) - 2048l}; pg8::SchedOutProj S{(const char*)(Pb + SLICE_ELEMS), (const char*)(p.ws + WS_WOUT) + (size_t)2048 * 2048 * 2, G, bid};
        pg8::EpiResid E{p.out, p.out, p.out, mod + 9 * 6144 + 4096};
        pg8::gemm_phase(lds, g, S, E); }
    SEAM(10);
    if (IN(11)) final_norm_phase(p);
#undef IN
#undef SEAM
}

extern "C" void kernel_launch(void* const* d_in, const int* in_sizes, int n_in, void* d_out, int out_size, void* d_ws, size_t ws_size, hipStream_t stream) {
    static int grid = 0;
    if (grid == 0) {
        int dev = 0, cus = 0, per_cu = 0;
        if (n_in != 22 || ws_size < WS_END) { fprintf(stderr, "kernel_launch: unexpected n_in %d / ws_size %zu (need %zu)\n", n_in, ws_size, (size_t)WS_END); grid = -1; return; }
        (void)hipGetDevice(&dev); (void)hipDeviceGetAttribute(&cus, hipDeviceAttributeMultiprocessorCount, dev);
        if (hipFuncSetAttribute((const void*)mk_fwd, hipFuncAttributeMaxDynamicSharedMemorySize, LDS_BYTES) != hipSuccess) { fprintf(stderr, "kernel_launch: hipFuncSetAttribute failed\n"); grid = -1; return; }
        if (hipOccupancyMaxActiveBlocksPerMultiprocessor(&per_cu, (const void*)mk_fwd, 512, LDS_BYTES) != hipSuccess || per_cu < 1) { fprintf(stderr, "kernel_launch: occupancy query says %d blocks per CU\n", per_cu); (void)hipGetLastError(); per_cu = 1; }
        grid = cus;
        (void)per_cu;
    }
    if (grid < 0) return;
    Params p{};
    const float** pp = (const float**)&p;
    for (int i = 0; i < 22; ++i) pp[i] = (const float*)d_in[i];
    p.out = (float*)d_out; p.ws = (unsigned char*)d_ws;
    if (hipMemsetAsync((char*)d_ws + WS_CTL, 0, 65536, stream) != hipSuccess) { fprintf(stderr, "kernel_launch: hipMemsetAsync failed\n"); return; }
#if MK_PER_PHASE_LAUNCH
    for (int ph = 0; ph < NPH; ++ph) { p.ph_lo = ph; p.ph_hi = ph + 1; hipLaunchKernelGGL(mk_fwd, dim3(grid), dim3(512), LDS_BYTES, stream, p); }
#else
    p.ph_lo = 0; p.ph_hi = NPH;
    void* args[] = {&p};
    hipError_t e = hipLaunchCooperativeKernel((const void*)mk_fwd, dim3(grid), dim3(512), args, LDS_BYTES, stream);
    if (e != hipSuccess) fprintf(stderr, "kernel_launch: cooperative launch failed: %s (grid %d)\n", hipGetErrorString(e), grid);
#endif
}
```

```cpp
#include <hip/hip_runtime.h>
#include <hip/hip_cooperative_groups.h>
#include <cstdio>
namespace cg = cooperative_groups;

#ifndef MK_PROBE
#define MK_PROBE -1
#endif
#ifndef MK_PER_PHASE_LAUNCH
#define MK_PER_PHASE_LAUNCH 0
#endif

#define LAS __attribute__((address_space(3)))
typedef unsigned short bf16_t;
typedef short bf16x8 __attribute__((ext_vector_type(8)));
typedef float f32x4 __attribute__((ext_vector_type(4)));
typedef float f32x2 __attribute__((ext_vector_type(2)));
typedef unsigned u32x4 __attribute__((ext_vector_type(4)));
typedef unsigned u32x2 __attribute__((ext_vector_type(2)));

constexpr int D = 2048, WB = 1024, NTOK = 24576, NPR = 8192;
constexpr int LDS_BYTES = 147456;
constexpr float EPSV = 1e-6f;
constexpr float LOG2E = 1.4426950408889634f;
constexpr size_t SLICE_ELEMS = (size_t)NTOK * WB;

constexpr size_t WS_CTL = 0;
constexpr size_t WS_MOD = 65536;
constexpr size_t WS_WG = WS_MOD + 524288;
constexpr size_t WS_ROPE = WS_WG + (1u << 20);
constexpr size_t WS_TAB1 = WS_ROPE + (1u << 20);
constexpr size_t WS_TAB2P = WS_TAB1 + (256u << 10);
constexpr size_t WS_TAB2S = WS_TAB2P + (256u << 10);
constexpr size_t WS_CARR = WS_TAB2S + (16u << 20);
constexpr size_t WS_WIN = WS_CARR + (6u << 20);
constexpr size_t WS_WOUT = WS_WIN + (48u << 20);
constexpr size_t WS_P = WS_WOUT + (16u << 20);
constexpr size_t WS_H = WS_P + (288ull << 20);
constexpr size_t WS_END = WS_H + (96ull << 20);
constexpr size_t OUT_SLRU = (size_t)NTOK * D;
constexpr size_t OUT_SRET = OUT_SLRU + 65536;

struct Params {
    const float *x_prompt, *x_sample, *state_lru, *state_ret, *c, *c_ctx, *norm_g, *ada_w, *ada_b, *w_in, *w_out,
        *lru_conv_w, *lru_conv_b, *lru_lambda, *lru_w_r, *lru_b_r, *lru_w_i, *lru_b_i, *ret_decay, *ret_norm_g, *sconv_w, *final_norm_g;
    float* out; unsigned char* ws; int ph_lo, ph_hi, li, pad;
};

__device__ __forceinline__ unsigned pk2(float lo, float hi) { unsigned r; asm("v_cvt_pk_bf16_f32 %0, %1, %2" : "=v"(r) : "v"(lo), "v"(hi)); return r; }
__device__ __forceinline__ bf16_t f2bf(float f) { return (bf16_t)(pk2(f, 0.f) & 0xffffu); }
__device__ __forceinline__ float bflo(unsigned u) { return __uint_as_float(u << 16); }
__device__ __forceinline__ float bfhi(unsigned u) { return __uint_as_float(u & 0xffff0000u); }
__device__ __forceinline__ float sigm(float x) { return __builtin_amdgcn_rcpf(1.f + __expf(-x)); }
__device__ __forceinline__ float silu(float x) { return x * sigm(x); }
__device__ __forceinline__ float wave_sum(float v) {
#pragma unroll
    for (int o = 1; o < 64; o <<= 1) v += __shfl_xor(v, o);
    return v;
}
#define LDS_FENCE() asm volatile("s_waitcnt lgkmcnt(0)" ::: "memory")

namespace pg8 {
constexpr int BM = 256, BK = 64, HALF = 128, HTB = HALF * BK * 2, STAGE_BYTES = 8 * HTB;
__device__ __forceinline__ int lds_byte(int r, int c) { const int st = (r >> 4) * 2 + (c >> 5), rr = r & 15, cc = c & 31, ob = rr * 64 + cc * 2; return st * 1024 + (ob ^ (((ob >> 9) & 1) << 5)); }
__device__ __forceinline__ void stage_rc(int b, int& R, int& C) { const int st = b / 1024, sb = b % 1024, swz = sb ^ (((sb >> 9) & 1) << 5); R = (st >> 1) * 16 + swz / 64; C = (st & 1) * 32 + (swz % 64) / 2; }
__device__ __forceinline__ int perm32(int rho) { const int n = rho >> 4, i = rho & 15; return 8 * (i >> 2) + 4 * n + (i & 3); }

struct GUnit { const char* A; const char* B; long coff; int aux, aux2; };
struct GCfg { int lda, ldb, nt, ksplit; long ksoff; };

template <class Epi, class Sched>
__device__ __forceinline__ void gemm_phase(LAS unsigned char* lds, const GCfg g, const Sched& S, const Epi& E) {
    const int tid = threadIdx.x, wid = __builtin_amdgcn_readfirstlane(tid >> 6), lane = tid & 63, wr = wid >> 2, wc = wid & 3, fr = lane & 15, fq = lane >> 4;
    const int nt = g.nt;
    unsigned voffA[2], voffB[2];
#pragma unroll
    for (int i = 0; i < 2; ++i) { int R, C; stage_rc(tid * 16 + i * 8192, R, C); const int Rb = Epi::PERM ? ((R & ~31) + perm32(R & 31)) : R;
        voffA[i] = (unsigned)(R * g.lda + C) * 2u; voffB[i] = (unsigned)(Rb * g.ldb + C) * 2u; }
    const size_t kstep = (size_t)(BK * 2);
    const size_t hstepA = (size_t)HALF * g.lda * 2, hstepB = (size_t)HALF * g.ldb * 2;
    const unsigned ldsw = (unsigned)wid * 1024u;
    const int aoff = lds_byte(wr * 64 + fr, fq * 8), boff = lds_byte(wc * 32 + fr, fq * 8);
#define PG8_AKT(base, t) ((base) + (size_t)(t) * kstep + ((t) >= g.ksplit ? g.ksoff : 0l))
#define PG8_SA(b, h) (((b) * 2 + (h)) * HTB)
#define PG8_SB(b, h) ((4 + (b) * 2 + (h)) * HTB)
#define PG8_STAGE(bufoff, gbase, voff) do { _Pragma("unroll") for (int _i = 0; _i < 2; ++_i) \
        __builtin_amdgcn_global_load_lds((const unsigned*)((const char*)(gbase) + (voff)[_i]), (LAS unsigned*)(lds + (bufoff) + ldsw + _i * 8192), 16, 0, 0); } while (0)
#define PG8_LDA(dst, b, h) do { _Pragma("unroll") for (int m = 0; m < 4; ++m) _Pragma("unroll") for (int k = 0; k < 2; ++k) dst[m][k] = *(const LAS bf16x8*)(lds + PG8_SA(b, h) + aoff + m * 2048 + k * 1024); } while (0)
#define PG8_LDB(dst, b, h) do { _Pragma("unroll") for (int n = 0; n < 2; ++n) _Pragma("unroll") for (int k = 0; k < 2; ++k) dst[n][k] = *(const LAS bf16x8*)(lds + PG8_SB(b, h) + boff + n * 2048 + k * 1024); } while (0)
#define PG8_MMA(ai, bj, At, Bt) do { __builtin_amdgcn_s_setprio(1); _Pragma("unroll") for (int m = 0; m < 4; ++m) _Pragma("unroll") for (int n = 0; n < 2; ++n) _Pragma("unroll") for (int k = 0; k < 2; ++k) \
        acc[ai][bj][m][n] = __builtin_amdgcn_mfma_f32_16x16x32_bf16(Bt[n][k], At[m][k], acc[ai][bj][m][n], 0, 0, 0); __builtin_amdgcn_s_setprio(0); } while (0)
#define PG8_WAIT_V(n) asm volatile("s_waitcnt vmcnt(" #n ")" ::: "memory")
#define PG8_WAIT_L(n) asm volatile("s_waitcnt lgkmcnt(" #n ")" ::: "memory")
#define PG8_BAR __builtin_amdgcn_s_barrier()
#define PG8_SCHED __builtin_amdgcn_sched_barrier(0)
    GUnit cur, nxt; int ui = 0;
    if (!S.next(0, cur)) return;
    f32x4 acc[2][2][4][2];
#pragma unroll
    for (int a = 0; a < 2; ++a)
#pragma unroll
        for (int b = 0; b < 2; ++b)
#pragma unroll
            for (int m = 0; m < 4; ++m)
#pragma unroll
                for (int n = 0; n < 2; ++n) acc[a][b][m][n] = (f32x4){0.f, 0.f, 0.f, 0.f};
    bf16x8 At[4][2], B0[2][2], B1[2][2];
    const char* cA = cur.A; const char* cB = cur.B;
    PG8_STAGE(PG8_SB(0, 0), cB, voffB); PG8_STAGE(PG8_SA(0, 0), cA, voffA); PG8_STAGE(PG8_SB(0, 1), cB + hstepB, voffB); PG8_STAGE(PG8_SA(0, 1), cA + hstepA, voffA);
    if (wr == 1) PG8_BAR;
    PG8_WAIT_V(4); PG8_BAR;
    PG8_STAGE(PG8_SB(1, 0), cB + kstep, voffB); PG8_STAGE(PG8_SA(1, 0), cA + kstep, voffA); PG8_STAGE(PG8_SB(1, 1), cB + hstepB + kstep, voffB);
    PG8_WAIT_V(6); PG8_BAR;
    for (;;) {
        const bool has_next = S.next(ui + 1, nxt);
        const char* nA = has_next ? nxt.A : cA; const char* nB = has_next ? nxt.B : cB;
        for (int t = 0; t < nt; t += 2) {
            const bool last = (t == nt - 2);
            const char* a1 = PG8_AKT(cA, t + 1);
            const char* a2 = last ? nA : PG8_AKT(cA, t + 2); const char* b2 = last ? nB : cB + (size_t)(t + 2) * kstep;
            const char* a3 = a2 + kstep; const char* b3 = b2 + kstep;
            PG8_LDB(B0, 0, 0); PG8_SCHED; PG8_LDA(At, 0, 0); PG8_STAGE(PG8_SA(1, 1), a1 + hstepA, voffA);
            PG8_WAIT_L(8); PG8_BAR; PG8_WAIT_L(0); PG8_MMA(0, 0, At, B0); PG8_BAR; PG8_SCHED;
            PG8_LDB(B1, 0, 1); PG8_STAGE(PG8_SB(0, 0), b2, voffB);
            PG8_BAR; PG8_WAIT_L(0); PG8_MMA(0, 1, At, B1); PG8_BAR;
            PG8_LDA(At, 0, 1); PG8_STAGE(PG8_SA(0, 0), a2, voffA);
            PG8_BAR; PG8_WAIT_L(0); PG8_MMA(1, 0, At, B0); PG8_BAR; PG8_SCHED;
            PG8_STAGE(PG8_SB(0, 1), b2 + hstepB, voffB);
            PG8_WAIT_V(6); PG8_BAR; PG8_MMA(1, 1, At, B1); PG8_BAR;
            PG8_LDB(B0, 1, 0); PG8_SCHED; PG8_LDA(At, 1, 0); PG8_STAGE(PG8_SA(0, 1), a2 + hstepA, voffA);
            PG8_WAIT_L(8); PG8_BAR; PG8_WAIT_L(0); PG8_MMA(0, 0, At, B0); PG8_BAR; PG8_SCHED;
            PG8_LDB(B1, 1, 1); PG8_STAGE(PG8_SB(1, 0), b3, voffB);
            PG8_BAR; PG8_WAIT_L(0); PG8_MMA(0, 1, At, B1); PG8_BAR;
            PG8_LDA(At, 1, 1); PG8_STAGE(PG8_SA(1, 0), a3, voffA);
            PG8_BAR; PG8_WAIT_L(0); PG8_MMA(1, 0, At, B0); PG8_BAR; PG8_SCHED;
            PG8_STAGE(PG8_SB(1, 1), b3 + hstepB, voffB);
            PG8_WAIT_V(6); PG8_BAR; PG8_MMA(1, 1, At, B1); PG8_BAR;
        }
        E(acc, cur, wr, wc, fr, fq);
        if (!has_next) break;
#pragma unroll
        for (int a = 0; a < 2; ++a)
#pragma unroll
            for (int b = 0; b < 2; ++b)
#pragma unroll
                for (int m = 0; m < 4; ++m)
#pragma unroll
                    for (int n = 0; n < 2; ++n) acc[a][b][m][n] = (f32x4){0.f, 0.f, 0.f, 0.f};
        cur = nxt; cA = nA; cB = nB; ++ui;
    }
    PG8_WAIT_V(0);
    if (wr == 0) PG8_BAR;
    PG8_BAR;
#undef PG8_AKT
#undef PG8_SA
#undef PG8_SB
#undef PG8_STAGE
#undef PG8_LDA
#undef PG8_LDB
#undef PG8_MMA
#undef PG8_WAIT_V
#undef PG8_WAIT_L
#undef PG8_BAR
#undef PG8_SCHED
}

__device__ __forceinline__ bool mn_order(int i, int G, int c, int nM, int nN, int& pm, int& pn) {
    const int nwg = nM * nN; const long L = (long)i * G + c; if (L >= nwg) return false;
    int wgid = (int)L; { const int q = nwg / 8, r = nwg % 8, xcd = wgid % 8, off = wgid / 8; wgid = (xcd < r ? xcd * (q + 1) : r * (q + 1) + (xcd - r) * q) + off; }
    const int nig = 8 * nN, gid = wgid / nig, fm = gid * 8, gsz = (nM - fm) < 8 ? (nM - fm) : 8;
    pm = fm + ((wgid % nig) % gsz); pn = (wgid % nig) / gsz; return true;
}
struct SchedInProj {
    const char* A; const char* B; int G, c;
    __device__ __forceinline__ bool next(int i, GUnit& u) const { int pm, pn; if (!mn_order(i, G, c, NTOK / 256, 24, pm, pn)) return false;
        u.A = A + (size_t)pm * 256 * 2048 * 2; u.B = B + (size_t)pn * 256 * 2048 * 2; u.coff = (long)((size_t)(pn >> 2) * SLICE_ELEMS + (size_t)pm * 256 * 1024 + (pn & 3) * 256); u.aux = pn >> 2; const int r0 = pm * 256; u.aux2 = r0 >= NPR ? ((r0 - NPR) & 2047) + 1 : 0; return true; }
};
struct SchedOutProj {
    const char* A; const char* B; int G, c;
    __device__ __forceinline__ bool next(int i, GUnit& u) const { int pm, pn; if (!mn_order(i, G, c, NTOK / 256, 8, pm, pn)) return false;
        u.A = A + (size_t)pm * 256 * 1024 * 2; u.B = B + (size_t)pn * 256 * 2048 * 2; u.coff = (long)((size_t)pm * 256 * 2048 + pn * 256);
        const int r0 = pm * 256; u.aux = r0 < NPR ? 8 : ((r0 - NPR) >> 11); u.aux2 = r0 >= NPR; return true; }
};
struct SchedF1 {
    const char* Tab1; const char* X0  ; int G, c, T, nb; long pqt0;
    __device__ __forceinline__ bool next(int i, GUnit& u) const { const int ntn = T >> 8; const long L = (long)i * G + c; if (L >= (long)nb * 8 * ntn) return false;
        const int tn = (int)(L % ntn), pm = (int)((L / ntn) & 1), gq = (int)((L / (2 * ntn)) & 3), b = (int)(L / (8 * ntn));
        u.A = Tab1 + (size_t)pm * 256 * 256 * 2; u.B = X0 + ((size_t)(b * T + tn * 256) * 1024 + gq * 256) * 2;
        u.coff = pqt0 + (long)(b * 1024 + gq * 256) * (2 * T) + (long)pm * T + tn * 256; u.aux = 0; u.aux2 = 0; return true; }
};
struct SchedF2 {
    const char* Tab2; const char* PQT0; int G, c, T, nb, rowbase;
    __device__ __forceinline__ bool next(int i, GUnit& u) const { const int nm = T >> 8; const long L = (long)i * G + c; if (L >= (long)nb * 4 * nm) return false;
        const int pm = (int)(L % nm), pn = (int)((L / nm) & 3), b = (int)(L / (4 * nm));
        u.A = Tab2 + (size_t)pm * 256 * (2 * T) * 2; u.B = PQT0 + ((size_t)(b * 1024 + pn * 256) * (2 * T)) * 2;
        u.coff = (long)(SLICE_ELEMS + (size_t)(rowbase + b * T + pm * 256) * 1024 + pn * 256); u.aux = 0; u.aux2 = 0; return true; }
};

struct EpiBf16Store {
    static constexpr bool PERM = true;
    bf16_t* O; int ldc;
    __device__ __forceinline__ void operator()(const f32x4 (&acc)[2][2][4][2], const GUnit& u, int wr, int wc, int fr, int fq) const {
        bf16_t* base = O + u.coff + (size_t)(wr * 64 + fr) * ldc + wc * 32 + 8 * fq;
#pragma unroll
        for (int ai = 0; ai < 2; ++ai)
#pragma unroll
            for (int m = 0; m < 4; ++m) { bf16_t* rowp = base + (size_t)(ai * HALF + m * 16) * ldc;
#pragma unroll
                for (int bj = 0; bj < 2; ++bj) { const f32x4 v0 = acc[ai][bj][m][0], v1 = acc[ai][bj][m][1];
                    u32x4 w; w.x = pk2(v0[0], v0[1]); w.y = pk2(v0[2], v0[3]); w.z = pk2(v1[0], v1[1]); w.w = pk2(v1[2], v1[3]);
                    *(u32x4*)(rowp + bj * HALF) = w; } }
    }
};
struct EpiInProjL0 {
    static constexpr bool PERM = true;
    bf16_t* O; const float* ropeC; const float* ropeS;
    __device__ __forceinline__ void operator()(const f32x4 (&acc)[2][2][4][2], const GUnit& u, int wr, int wc, int fr, int fq) const {
        bf16_t* base = O + u.coff + (size_t)(wr * 64 + fr) * 1024 + wc * 32 + 8 * fq;
        const bool qk = (u.aux == 2 || u.aux == 3), rope = qk && u.aux2 > 0; const float scl = u.aux == 3 ? 0.08838834764831845f : 1.0f;
        const int f0 = 16 * wc + 4 * fq;
#pragma unroll
        for (int ai = 0; ai < 2; ++ai)
#pragma unroll
            for (int m = 0; m < 4; ++m) { bf16_t* rowp = base + (size_t)(ai * HALF + m * 16) * 1024;
                f32x4 cs = (f32x4){1.f, 1.f, 1.f, 1.f}, sn = (f32x4){0.f, 0.f, 0.f, 0.f};
                if (rope) { const int t = (u.aux2 - 1) + ai * HALF + wr * 64 + m * 16 + fr; cs = *(const f32x4*)(ropeC + t * 64 + f0); sn = *(const f32x4*)(ropeS + t * 64 + f0); }
#pragma unroll
                for (int bj = 0; bj < 2; ++bj) { f32x4 v0 = acc[ai][bj][m][0], v1 = acc[ai][bj][m][1];
                    if (qk) { const f32x4 a0 = v0, a1 = v1;
                        v0[0] = (a0[0] * cs[0] - a0[1] * sn[0]) * scl; v0[1] = (a0[0] * sn[0] + a0[1] * cs[0]) * scl; v0[2] = (a0[2] * cs[1] - a0[3] * sn[1]) * scl; v0[3] = (a0[2] * sn[1] + a0[3] * cs[1]) * scl;
                        v1[0] = (a1[0] * cs[2] - a1[1] * sn[2]) * scl; v1[1] = (a1[0] * sn[2] + a1[1] * cs[2]) * scl; v1[2] = (a1[2] * cs[3] - a1[3] * sn[3]) * scl; v1[3] = (a1[2] * sn[3] + a1[3] * cs[3]) * scl; }
                    u32x4 w; w.x = pk2(v0[0], v0[1]); w.y = pk2(v0[2], v0[3]); w.z = pk2(v1[0], v1[1]); w.w = pk2(v1[2], v1[3]);
                    *(u32x4*)(rowp + bj * HALF) = w; } }
    }
};
struct EpiSiluInPlace {
    static constexpr bool PERM = true;
    bf16_t* O;
    __device__ __forceinline__ void operator()(const f32x4 (&acc)[2][2][4][2], const GUnit& u, int wr, int wc, int fr, int fq) const {
        bf16_t* base = O + u.coff + (size_t)(wr * 64 + fr) * 1024 + wc * 32 + 8 * fq;
#pragma unroll
        for (int ai = 0; ai < 2; ++ai)
#pragma unroll
            for (int m = 0; m < 4; ++m) { bf16_t* rowp = base + (size_t)(ai * HALF + m * 16) * 1024;
#pragma unroll
                for (int bj = 0; bj < 2; ++bj) { const f32x4 v0 = acc[ai][bj][m][0], v1 = acc[ai][bj][m][1];
                    const u32x4 gv = *(const u32x4*)(rowp + bj * HALF);
                    u32x4 w; w.x = pk2(v0[0] * silu(bflo(gv.x)), v0[1] * silu(bfhi(gv.x))); w.y = pk2(v0[2] * silu(bflo(gv.y)), v0[3] * silu(bfhi(gv.y)));
                    w.z = pk2(v1[0] * silu(bflo(gv.z)), v1[1] * silu(bfhi(gv.z))); w.w = pk2(v1[2] * silu(bflo(gv.w)), v1[3] * silu(bfhi(gv.w)));
                    *(u32x4*)(rowp + bj * HALF) = w; } }
    }
};
struct EpiResid {
    static constexpr bool PERM = false;
    const float* xin0; const float* xin1; float* out; const float* gate;
    __device__ __forceinline__ void operator()(const f32x4 (&acc)[2][2][4][2], const GUnit& u, int wr, int wc, int fr, int fq) const {
        const size_t off0 = (size_t)u.coff + (size_t)(wr * 64 + fr) * 2048 + wc * 32 + 4 * fq;
        const int col0 = (int)(u.coff & 2047) + wc * 32 + 4 * fq;
        const float* xb = u.aux2 ? xin1 : xin0; const float* gp = gate + (size_t)u.aux * 6144 + col0;
        f32x4 gv[2][2];
#pragma unroll
        for (int bj = 0; bj < 2; ++bj)
#pragma unroll
            for (int n = 0; n < 2; ++n) gv[bj][n] = *(const f32x4*)(gp + bj * HALF + n * 16);
#pragma unroll
        for (int ai = 0; ai < 2; ++ai)
#pragma unroll
            for (int m = 0; m < 4; ++m) { const size_t off = off0 + (size_t)(ai * HALF + m * 16) * 2048;
#pragma unroll
                for (int bj = 0; bj < 2; ++bj)
#pragma unroll
                    for (int n = 0; n < 2; ++n) { const f32x4 xv = *(const f32x4*)(xb + off + bj * HALF + n * 16);
                        *(f32x4*)(out + off + bj * HALF + n * 16) = xv + gv[bj][n] * acc[ai][bj][m][n]; } }
    }
};
}

__device__ __forceinline__ void mod_unit(const Params& p, LAS unsigned char* lds, int u) {
    const int tid = threadIdx.x, lane = tid & 63, wave = tid >> 6;
    LAS float* scond = (LAS float*)lds;
    for (int i = tid; i < 9 * 2048; i += 512) { const int ci = i >> 11, k = i & 2047; const float v = ci < 8 ? p.c[ci * 2048 + k] : p.c_ctx[k]; scond[i] = silu(v); }
    __syncthreads();
    const int l = u / 48, n0 = (u % 48) * 128, ct = lane & 31, rg = 2 * wave + (lane >> 5);
    const float* Wp = p.ada_w + (size_t)l * 2048 * 6144 + n0 + ct * 4;
    float acc[9][4];
#pragma unroll
    for (int ci = 0; ci < 9; ++ci)
#pragma unroll
        for (int j = 0; j < 4; ++j) acc[ci][j] = 0.f;
#pragma unroll 8
    for (int k = rg; k < 2048; k += 16) {
        const f32x4 w = *(const f32x4*)(Wp + (size_t)k * 6144);
#pragma unroll
        for (int ci = 0; ci < 9; ++ci) { const float s = scond[ci * 2048 + k]; acc[ci][0] += s * w[0]; acc[ci][1] += s * w[1]; acc[ci][2] += s * w[2]; acc[ci][3] += s * w[3]; }
    }
#pragma unroll
    for (int ci = 0; ci < 9; ++ci)
#pragma unroll
        for (int j = 0; j < 4; ++j) acc[ci][j] += __shfl_xor(acc[ci][j], 32);
    __syncthreads();
    LAS float* red = (LAS float*)lds;
    if (lane < 32) {
#pragma unroll
        for (int ci = 0; ci < 9; ++ci)
#pragma unroll
            for (int j = 0; j < 4; ++j) red[(wave * 32 + ct) * 36 + ci * 4 + j] = acc[ci][j];
    }
    __syncthreads();
    float* mod = (float*)(p.ws + WS_MOD);
    for (int o = tid; o < 9 * 128; o += 512) { const int ci = o >> 7, col = o & 127, ct2 = col >> 2, j = col & 3; float s = 0.f;
#pragma unroll
        for (int w = 0; w < 8; ++w) s += red[(w * 32 + ct2) * 36 + ci * 4 + j];
        mod[(size_t)(l * 9 + ci) * 6144 + n0 + col] = s + p.ada_b[l * 6144 + n0 + col]; }
    __syncthreads();
}
__device__ __forceinline__ int qk_perm_row(int n) { return (n >= 2048 && n < 4096) ? ((n & ~127) | ((n & 63) << 1) | ((n >> 6) & 1)) : n; }
__device__ __forceinline__ void transpose_item(const float* Wm, int K, int N, bf16_t* WT, LAS float* scr, int item, int lane, bool qkperm) {
    const int nblk = N / 64, kb = item / nblk, nb = item % nblk, k0 = 64 * kb, n0 = 64 * nb;
#pragma unroll 8
    for (int i = 0; i < 64; ++i) scr[i * 65 + lane] = Wm[(size_t)(k0 + i) * N + n0 + lane];
    LDS_FENCE();
    const int cc = lane & 7;
#pragma unroll
    for (int j = 0; j < 8; ++j) { const int n = (lane >> 3) + 8 * j; const LAS float* s = scr + (8 * cc) * 65 + n;
        u32x4 o; o.x = pk2(s[0 * 65], s[1 * 65]); o.y = pk2(s[2 * 65], s[3 * 65]); o.z = pk2(s[4 * 65], s[5 * 65]); o.w = pk2(s[6 * 65], s[7 * 65]);
        const int nr = qkperm ? qk_perm_row(n0 + n) : n0 + n;
        *(u32x4*)(WT + (size_t)nr * K + k0 + 8 * cc) = o; }
    LDS_FENCE();
}
__device__ __forceinline__ void ph0_prep(const Params& p, LAS unsigned char* lds) {
    const int tid = threadIdx.x, lane = tid & 63, wave = tid >> 6, G = gridDim.x, bid = blockIdx.x;
    for (int u = bid; u < 96; u += G) mod_unit(p, lds, u);
    { LAS float* scr = (LAS float*)(lds + wave * 16640);
      const int gw = bid * 8 + wave, NGW = G * 8;
      bf16_t* WinT = (bf16_t*)(p.ws + WS_WIN); bf16_t* WoutT = (bf16_t*)(p.ws + WS_WOUT);
      constexpr int I_IN = 32 * 96, I_OUT = 32 * 32;
      for (int it = gw; it < 2 * I_IN + 2 * I_OUT; it += NGW) {
          int r = it;
          if (r < 2 * I_IN) { const int l = r / I_IN; r -= l * I_IN; transpose_item(p.w_in + (size_t)l * 2048 * 6144, 2048, 6144, WinT + (size_t)l * 6144 * 2048, scr, r, lane, l == 0); }
          else { r -= 2 * I_IN; const int l = r / I_OUT; r -= l * I_OUT; transpose_item(p.w_out + (size_t)l * 2048 * 2048, 2048, 2048, WoutT + (size_t)l * 2048 * 2048, scr, r, lane, false); }
      } }
    const int gt = bid * 512 + tid, NT = G * 512;
    { bf16_t* Wg = (bf16_t*)(p.ws + WS_WG);
      for (int idx = gt; idx < 8 * 512 * 128; idx += NT) { const int i = idx & 127, n = (idx >> 7) & 511, h = idx >> 16, g = n >> 7, j = n & 127;
          const float* src = (g & 1) ? p.lru_w_i : p.lru_w_r; const int dir = g >> 1;
          Wg[idx] = f2bf(src[((size_t)(dir * 8 + h) * 128 + i) * 128 + j]); } }
    { float* rc = (float*)(p.ws + WS_ROPE); float* rs = rc + 2048 * 64;
      for (int idx = gt; idx < 2048 * 64; idx += NT) { const int f = idx & 63, t = idx >> 6; const float pos = (f < 32) ? (float)(t >> 6) : (float)(t & 63);
          const float fr = powf(10000.0f, -(float)(f & 31) / 32.0f); const float ang = pos * fr; rc[idx] = cosf(ang); rs[idx] = sinf(ang); } }
    { bf16_t* T1 = (bf16_t*)(p.ws + WS_TAB1);
      for (int i8 = gt; i8 < 512 * 256 / 8; i8 += NT) { const int j = (i8 * 8) >> 8, c0 = (i8 * 8) & 255; float v[8];
#pragma unroll
          for (int e = 0; e < 8; ++e) { const int m = ((j & 255) * (c0 + e)) & 255; const float a = (float)m * (2.0f / 256.0f); v[e] = (j < 256 ? cospif(a) : sinpif(a)) * 0.0625f; }
          u32x4 o; o.x = pk2(v[0], v[1]); o.y = pk2(v[2], v[3]); o.z = pk2(v[4], v[5]); o.w = pk2(v[6], v[7]); *(u32x4*)(T1 + (size_t)i8 * 8) = o; } }
#pragma unroll
    for (int which = 0; which < 2; ++which) {
        const int T = which ? 2048 : 256; const int sh = which ? 12 : 9;
        bf16_t* T2 = (bf16_t*)(p.ws + (which ? WS_TAB2S : WS_TAB2P)); const float sc = which ? 0.02209708691207961f : 0.0625f;
        for (int i8 = gt; i8 < T * 2 * T / 8; i8 += NT) { const int k1 = (i8 * 8) >> sh, c0 = (i8 * 8) & (2 * T - 1); float v[8];
#pragma unroll
            for (int e = 0; e < 8; ++e) { const int col = c0 + e, t = col & (T - 1); const int m = (k1 * t) & (T - 1); const float a = (float)m * (2.0f / (float)T);
                v[e] = (col < T ? cospif(a) : -sinpif(a)) * sc; }
            u32x4 o; o.x = pk2(v[0], v[1]); o.y = pk2(v[2], v[3]); o.z = pk2(v[4], v[5]); o.w = pk2(v[6], v[7]); *(u32x4*)(T2 + (size_t)i8 * 8) = o; }
    }
}

__device__ __forceinline__ void normmod_phase(const Params& p, const float* x0, const float* x1  , int l) {
    const int tid = threadIdx.x, lane = tid & 63, wave = tid >> 6;
    const float* mod = (const float*)(p.ws + WS_MOD) + (size_t)l * 9 * 6144; const float* ng = p.norm_g + l * 2048;
    bf16_t* H = (bf16_t*)(p.ws + WS_H);
    for (int row = blockIdx.x * 8 + wave; row < NTOK; row += gridDim.x * 8) {
        const float* xr = (row < NPR ? x0 : x1) + (size_t)row * D; const int ci = row < NPR ? 8 : ((row - NPR) >> 11);
        f32x4 v[8]; float ss = 0.f;
#pragma unroll
        for (int j = 0; j < 8; ++j) { v[j] = *(const f32x4*)(xr + 4 * lane + 256 * j); ss += (v[j][0] * v[j][0] + v[j][1] * v[j][1]) + (v[j][2] * v[j][2] + v[j][3] * v[j][3]); }
        const float rstd = 1.0f / sqrtf(wave_sum(ss) * (1.0f / 2048.0f) + EPSV);
        const float* sh = mod + (size_t)ci * 6144; const float* sc = sh + 2048;
#pragma unroll
        for (int j = 0; j < 8; ++j) { const int col = 4 * lane + 256 * j; const f32x4 g = *(const f32x4*)(ng + col), s1 = *(const f32x4*)(sc + col), s0 = *(const f32x4*)(sh + col);
            const f32x4 hv = (v[j] * rstd * g) * (1.0f + s1) + s0;
            u32x2 o; o.x = pk2(hv[0], hv[1]); o.y = pk2(hv[2], hv[3]); *(u32x2*)(H + (size_t)row * D + col) = o; }
    }
}

typedef short s16x4 __attribute__((ext_vector_type(4)));
__device__ __forceinline__ unsigned off_b(unsigned row, unsigned ch) { return 256u * row + 16u * (ch ^ (((row & 3u) << 2) | ((row >> 2) & 3u))); }
__device__ __forceinline__ bf16x8 row_frag(LAS unsigned char* T, int rb, int s, int lane) { return *(const LAS bf16x8*)(T + off_b((unsigned)((lane & 15) + 16 * rb), (unsigned)(4 * s + (lane >> 4)))); }
__device__ __forceinline__ bf16x8 tr_frag(LAS unsigned char* T, int r0, int r1, int c, int lane) {
    const unsigned qq = (unsigned)(lane & 15) >> 2, pp = (unsigned)lane & 3u;
    const s16x4 x = __builtin_amdgcn_ds_read_tr16_b64_v4i16((LAS s16x4*)(T + off_b((unsigned)r0 + qq, 2u * (unsigned)c + (pp >> 1)) + 8u * (pp & 1u)));
    const s16x4 y = __builtin_amdgcn_ds_read_tr16_b64_v4i16((LAS s16x4*)(T + off_b((unsigned)r1 + qq, 2u * (unsigned)c + (pp >> 1)) + 8u * (pp & 1u)));
    return (bf16x8){x[0], x[1], x[2], x[3], y[0], y[1], y[2], y[3]};
}
__device__ __forceinline__ int ret_slot(int seq, int h, int dir, int ch) { return seq < 32 ? (((seq * 8 + h) * 2 + dir) * 2 + ch) : (1024 + ((((seq - 32) * 8 + h) * 2 + dir) * 16 + ch)); }

__device__ __forceinline__ void ret_chain(const Params& p, LAS unsigned char* lds, int seq, int h, int dir) {
    const int tid = threadIdx.x, lane = tid & 63, w = tid >> 6, q = lane >> 4, fr = lane & 15;
    const bool smp = seq >= 32; const int nch = smp ? 16 : 2; const int rb = smp ? NPR + (seq - 32) * 2048 : seq * 256;
    const bf16_t* Pk = (const bf16_t*)(p.ws + WS_P) + 3 * SLICE_ELEMS; const bf16_t* Pv = (const bf16_t*)(p.ws + WS_P) + 4 * SLICE_ELEMS;
    bf16_t* Sbuf = (bf16_t*)(p.ws + WS_H);
    const float lg2 = -log1pf(expf(-p.ret_decay[dir * 8 + h])) * LOG2E;
    const float cd = exp2f(lg2 * 128.0f);
    f32x4 acc[8];
    if (smp) { const float* S0 = p.state_ret + (size_t)(((seq - 32) * 2 + dir) * 8 + h) * 16384;
#pragma unroll
        for (int nb = 0; nb < 8; ++nb)
#pragma unroll
            for (int r = 0; r < 4; ++r) { const int dp = 16 * w + 4 * q + r, d = ((dp & 1) << 6) | (dp >> 1); acc[nb][r] = S0[d * 128 + 16 * nb + fr]; } }
    else {
#pragma unroll
        for (int nb = 0; nb < 8; ++nb) acc[nb] = (f32x4){0.f, 0.f, 0.f, 0.f}; }
    u32x4 kreg[4], vreg[4];
#define RET_ISSUE(chunk) do { _Pragma("unroll") for (int rep = 0; rep < 4; ++rep) { const int it = tid + 512 * rep, chk = it & 15, row = it >> 4; const size_t go = (size_t)(rb + (chunk) * 128 + row) * 1024 + h * 128 + chk * 8; \
        kreg[rep] = *(const u32x4*)(Pk + go); vreg[rep] = *(const u32x4*)(Pv + go); } } while (0)
    RET_ISSUE(dir ? nch - 1 : 0);
    for (int step = 0; step < nch; ++step) {
        const int ch = dir ? nch - 1 - step : step;
        { bf16_t* Sd = Sbuf + (size_t)ret_slot(seq, h, dir, ch) * 16384;
#pragma unroll
          for (int nb = 0; nb < 8; ++nb) { u32x2 v; v.x = pk2(acc[nb][0], acc[nb][1]); v.y = pk2(acc[nb][2], acc[nb][3]); *(u32x2*)(Sd + (16 * nb + fr) * 128 + 16 * w + 4 * q) = v; } }
        LAS unsigned char* Kb = lds + (step & 1) * 65536; LAS unsigned char* Vb = Kb + 32768;
#pragma unroll
        for (int rep = 0; rep < 4; ++rep) { const int it = tid + 512 * rep, chk = it & 15, row = it >> 4;
            const float dec = exp2f(lg2 * (float)(dir ? row : 127 - row)); const u32x4 a = kreg[rep]; u32x4 o;
            o.x = pk2(bflo(a.x) * dec, bfhi(a.x) * dec); o.y = pk2(bflo(a.y) * dec, bfhi(a.y) * dec); o.z = pk2(bflo(a.z) * dec, bfhi(a.z) * dec); o.w = pk2(bflo(a.w) * dec, bfhi(a.w) * dec);
            *(LAS u32x4*)(Kb + off_b(row, chk)) = o; *(LAS u32x4*)(Vb + off_b(row, chk)) = vreg[rep]; }
        __syncthreads();
        if (step + 1 < nch) RET_ISSUE(dir ? nch - 2 - step : step + 1);
#pragma unroll
        for (int nb = 0; nb < 8; ++nb) acc[nb] = acc[nb] * cd;
#pragma unroll 1
        for (int ks = 0; ks < 4; ++ks) { const bf16x8 A = tr_frag(Kb, 32 * ks + 8 * q, 32 * ks + 8 * q + 4, w, lane);
#pragma unroll
            for (int nb = 0; nb < 8; ++nb) { const bf16x8 B = tr_frag(Vb, 32 * ks + 8 * q, 32 * ks + 8 * q + 4, nb, lane); acc[nb] = __builtin_amdgcn_mfma_f32_16x16x32_bf16(A, B, acc[nb], 0, 0, 0); } }
    }
#undef RET_ISSUE
    if (!smp) { float* So = p.out + OUT_SRET + (size_t)((seq * 2 + dir) * 8 + h) * 16384;
#pragma unroll
        for (int nb = 0; nb < 8; ++nb)
#pragma unroll
            for (int r = 0; r < 4; ++r) { const int dp = 16 * w + 4 * q + r, d = ((dp & 1) << 6) | (dp >> 1); So[d * 128 + 16 * nb + fr] = acc[nb][r]; } }
    __syncthreads();
}

__device__ __forceinline__ void ret_out_unit(const Params& p, LAS unsigned char* lds, int gch, int h, bf16_t* dry) {
    const int tid = threadIdx.x, lane = tid & 63, w = tid >> 6, q = lane >> 4, fr = lane & 15;
    LAS unsigned char* R0 = lds; LAS unsigned char* R1 = lds + 32768; LAS unsigned char* R2 = lds + 65536;
    const bool smp = gch >= 64; const int seq = smp ? 32 + ((gch - 64) >> 4) : (gch >> 1); const int ch = smp ? ((gch - 64) & 15) : (gch & 1);
    const size_t row0 = (size_t)gch * 128;
    const bf16_t* Pq = (const bf16_t*)(p.ws + WS_P) + 2 * SLICE_ELEMS; const bf16_t* Pk = Pq + SLICE_ELEMS; const bf16_t* Pv = Pk + SLICE_ELEMS; bf16_t* Pg = (bf16_t*)(p.ws + WS_P) + 5 * SLICE_ELEMS;
    const bf16_t* Sf = (const bf16_t*)(p.ws + WS_H) + (size_t)ret_slot(seq, h, 0, ch) * 16384; const bf16_t* Sb = (const bf16_t*)(p.ws + WS_H) + (size_t)ret_slot(seq, h, 1, ch) * 16384;
    const float lgf = -log1pf(expf(-p.ret_decay[h])) * LOG2E, lgb = -log1pf(expf(-p.ret_decay[8 + h])) * LOG2E;
    LAS unsigned char* R3 = lds + 98304;
    u32x4 vreg[4];
#pragma unroll
    for (int rep = 0; rep < 4; ++rep) { const int it = tid + 512 * rep, chk = it & 15, row = it >> 4; const size_t go = (row0 + row) * 1024 + h * 128 + chk * 8;
        *(LAS u32x4*)(R0 + off_b(row, chk)) = *(const u32x4*)(Pq + go); *(LAS u32x4*)(R1 + off_b(row, chk)) = *(const u32x4*)(Sf + row * 128 + chk * 8); *(LAS u32x4*)(R2 + off_b(row, chk)) = *(const u32x4*)(Sb + row * 128 + chk * 8);
        *(LAS u32x4*)(R3 + off_b(row, chk)) = *(const u32x4*)(Pk + go); vreg[rep] = *(const u32x4*)(Pv + go); }
    __syncthreads();
    bf16x8 bQ[4];
#pragma unroll
    for (int ks = 0; ks < 4; ++ks) bQ[ks] = row_frag(R0, w, ks, lane);
    const int tl = 16 * w + fr;
    const float decf = exp2f(lgf * (float)(tl + 1)), decb = exp2f(lgb * (float)(128 - tl));
    f32x4 o[8];
#pragma unroll
    for (int eb = 0; eb < 8; ++eb) { f32x4 s1 = (f32x4){0.f, 0.f, 0.f, 0.f}, s2 = s1;
#pragma unroll
        for (int ks = 0; ks < 4; ++ks) { s1 = __builtin_amdgcn_mfma_f32_16x16x32_bf16(row_frag(R1, eb, ks, lane), bQ[ks], s1, 0, 0, 0); s2 = __builtin_amdgcn_mfma_f32_16x16x32_bf16(row_frag(R2, eb, ks, lane), bQ[ks], s2, 0, 0, 0); }
        o[eb] = s1 * decf + s2 * decb; __builtin_amdgcn_sched_barrier(0); }
    __syncthreads();
#pragma unroll
    for (int rep = 0; rep < 4; ++rep) { const int it = tid + 512 * rep, chk = it & 15, row = it >> 4; *(LAS u32x4*)(R2 + off_b(row, chk)) = vreg[rep]; }
    __syncthreads();
    bf16x8 pB[4];
#pragma unroll
    for (int k2 = 0; k2 < 4; ++k2) { f32x4 sa = (f32x4){0.f, 0.f, 0.f, 0.f}, sb = sa;
#pragma unroll
        for (int ks = 0; ks < 4; ++ks) { sa = __builtin_amdgcn_mfma_f32_16x16x32_bf16(row_frag(R3, 2 * k2, ks, lane), bQ[ks], sa, 0, 0, 0); sb = __builtin_amdgcn_mfma_f32_16x16x32_bf16(row_frag(R3, 2 * k2 + 1, ks, lane), bQ[ks], sb, 0, 0, 0); }
#pragma unroll
        for (int r = 0; r < 4; ++r) { const int da = tl - (32 * k2 + 4 * q + r), db = da - 16;
            sa[r] *= da > 0 ? exp2f(lgf * (float)da) : (da < 0 ? exp2f(lgb * (float)(-da)) : 2.0f);
            sb[r] *= db > 0 ? exp2f(lgf * (float)db) : (db < 0 ? exp2f(lgb * (float)(-db)) : 2.0f); }
        u32x4 pk; pk.x = pk2(sa[0], sa[1]); pk.y = pk2(sa[2], sa[3]); pk.z = pk2(sb[0], sb[1]); pk.w = pk2(sb[2], sb[3]);
        pB[k2] = __builtin_bit_cast(bf16x8, pk); __builtin_amdgcn_sched_barrier(0); }
#pragma unroll
    for (int eb = 0; eb < 8; ++eb) {
#pragma unroll
        for (int k2 = 0; k2 < 4; ++k2) { const bf16x8 aV = tr_frag(R2, 32 * k2 + 4 * q, 32 * k2 + 16 + 4 * q, eb, lane); o[eb] = __builtin_amdgcn_mfma_f32_16x16x32_bf16(aV, pB[k2], o[eb], 0, 0, 0); }
        if (eb & 1) __builtin_amdgcn_sched_barrier(0); }
    float ss = 0.f;
#pragma unroll
    for (int eb = 0; eb < 8; ++eb) ss += (o[eb][0] * o[eb][0] + o[eb][1] * o[eb][1]) + (o[eb][2] * o[eb][2] + o[eb][3] * o[eb][3]);
    ss += __shfl_xor(ss, 16); ss += __shfl_xor(ss, 32);
    const float rstd = 1.0f / sqrtf(ss * (1.0f / 128.0f) + EPSV);
#pragma unroll
    for (int eb = 0; eb < 8; ++eb) { const int col = h * 128 + 16 * eb + 4 * q; const size_t off = (row0 + tl) * 1024 + col;
        const f32x4 g = *(const f32x4*)(p.ret_norm_g + col); const u32x2 gt = *(const u32x2*)(Pg + off);
        u32x2 y; y.x = pk2(o[eb][0] * rstd * g[0] * silu(bflo(gt.x)), o[eb][1] * rstd * g[1] * silu(bfhi(gt.x))); y.y = pk2(o[eb][2] * rstd * g[2] * silu(bflo(gt.y)), o[eb][3] * rstd * g[3] * silu(bfhi(gt.y)));
        *(u32x2*)((dry ? dry : Pg) + off) = y; }
    __syncthreads();
}

template <bool FWD>
__device__ __forceinline__ void tile_scan(float (&a)[4][4], float (&b)[4][4], int q, int lane, float& Atot, float& Btot) {
    float As[4], Bs[4], At[4], Bt[4], Ae[4], Be[4];
#pragma unroll
    for (int mb = 0; mb < 4; ++mb) {
        if (FWD) { float A = a[mb][0], B = b[mb][0];
#pragma unroll
            for (int r = 1; r < 4; ++r) { B = B * a[mb][r] + b[mb][r]; A *= a[mb][r]; } As[mb] = A; Bs[mb] = B; }
        else { float A = a[mb][3], B = b[mb][3];
#pragma unroll
            for (int r = 2; r >= 0; --r) { B = B * a[mb][r] + b[mb][r]; A *= a[mb][r]; } As[mb] = A; Bs[mb] = B; }
    }
    const int n1 = FWD ? lane - 16 : lane + 16, n2 = FWD ? lane - 32 : lane + 32;
    const bool v1 = FWD ? (q >= 1) : (q <= 2), v2 = FWD ? (q >= 2) : (q <= 1);
#pragma unroll
    for (int mb = 0; mb < 4; ++mb) {
        const float A1 = __shfl(As[mb], n1), B1 = __shfl(Bs[mb], n1);
        if (v1) { Bs[mb] = B1 * As[mb] + Bs[mb]; As[mb] = A1 * As[mb]; }
        const float A2 = __shfl(As[mb], n2), B2 = __shfl(Bs[mb], n2);
        if (v2) { Bs[mb] = B2 * As[mb] + Bs[mb]; As[mb] = A2 * As[mb]; }
    }
    const int ntot = FWD ? (lane & 15) + 48 : (lane & 15);
#pragma unroll
    for (int mb = 0; mb < 4; ++mb) { At[mb] = __shfl(As[mb], ntot); Bt[mb] = __shfl(Bs[mb], ntot);
        const float ae = __shfl(As[mb], n1), be = __shfl(Bs[mb], n1); Ae[mb] = v1 ? ae : 1.0f; Be[mb] = v1 ? be : 0.0f; }
    float Ac = 1.0f, Bc = 0.0f;
#pragma unroll
    for (int i = 0; i < 4; ++i) { const int mb = FWD ? i : 3 - i;
        float cum = Ac * Ae[mb], hh = Bc * Ae[mb] + Be[mb];
#pragma unroll
        for (int j = 0; j < 4; ++j) { const int r = FWD ? j : 3 - j; hh = a[mb][r] * hh + b[mb][r]; cum = cum * a[mb][r]; b[mb][r] = hh; a[mb][r] = cum; }
        Bc = Bc * At[mb] + Bt[mb]; Ac = Ac * At[mb]; }
    Atot = Ac; Btot = Bc;
}
__device__ __forceinline__ void lru_pass1_unit(const Params& p, LAS unsigned char* lds, int gt, int h) {
    const int tid = threadIdx.x, lane = tid & 63, w = tid >> 6, q = lane >> 4, fr = lane & 15;
    LAS float* Uf = (LAS float*)lds;
    LAS unsigned char* Ub = lds + 33792;
    LAS unsigned char* Ot = lds + 33792 + 17408;
    const bf16_t* xa = (const bf16_t*)(p.ws + WS_P);
    const int T = gt < 128 ? 256 : 2048, t0 = gt < 128 ? (gt & 3) * 64 : ((gt - 128) & 31) * 64; const size_t row0 = (size_t)gt * 64;
    bf16x8 bW[4][4];
    { const bf16_t* Wg = (const bf16_t*)(p.ws + WS_WG) + (size_t)h * 512 * 128;
#pragma unroll
      for (int g = 0; g < 4; ++g)
#pragma unroll
          for (int ks = 0; ks < 4; ++ks) bW[g][ks] = *(const bf16x8*)(Wg + (size_t)(g * 128 + 16 * w + fr) * 128 + 32 * ks + 8 * q); }
    { const int c2 = tid & 63, tg = tid >> 6, hc = h * 128 + 2 * c2;
      const f32x2 w0 = *(const f32x2*)(p.lru_conv_w + hc), w1 = *(const f32x2*)(p.lru_conv_w + 1024 + hc), w2 = *(const f32x2*)(p.lru_conv_w + 2048 + hc), w3 = *(const f32x2*)(p.lru_conv_w + 3072 + hc), bb = *(const f32x2*)(p.lru_conv_b + hc);
      float x0[11], x1[11];
#pragma unroll
      for (int i = 0; i < 11; ++i) { const int tl = tg * 8 - 2 + i, tt = t0 + tl; unsigned v = 0u; if (tt >= 0 && tt < T) v = *(const unsigned*)(xa + (size_t)((long)row0 + tl) * 1024 + hc); x0[i] = bflo(v); x1[i] = bfhi(v); }
#pragma unroll
      for (int j = 0; j < 8; ++j) { const float u0 = w0[0] * x0[j] + w1[0] * x0[j + 1] + w2[0] * x0[j + 2] + w3[0] * x0[j + 3] + bb[0];
          const float u1 = w0[1] * x1[j] + w1[1] * x1[j + 1] + w2[1] * x1[j + 2] + w3[1] * x1[j + 3] + bb[1]; const int tl = tg * 8 + j;
          *(LAS f32x2*)(Uf + tl * 132 + 2 * c2) = (f32x2){u0, u1}; *(LAS unsigned*)(Ub + tl * 272 + 4 * c2) = pk2(u0, u1); } }
    __syncthreads();
    float ga[4][4][4];
    { bf16x8 aU[4][4];
#pragma unroll
      for (int mb = 0; mb < 4; ++mb)
#pragma unroll
          for (int ks = 0; ks < 4; ++ks) aU[mb][ks] = *(const LAS bf16x8*)(Ub + (16 * mb + fr) * 272 + (32 * ks + 8 * q) * 2);
#pragma unroll
      for (int g = 0; g < 4; ++g) {
#pragma unroll
          for (int mb = 0; mb < 4; ++mb) { f32x4 s = (f32x4){0.f, 0.f, 0.f, 0.f};
#pragma unroll
              for (int ks = 0; ks < 4; ++ks) s = __builtin_amdgcn_mfma_f32_16x16x32_bf16(aU[mb][ks], bW[g][ks], s, 0, 0, 0);
              ga[g][mb][0] = s[0]; ga[g][mb][1] = s[1]; ga[g][mb][2] = s[2]; ga[g][mb][3] = s[3]; } } }
    const int hc = h * 128 + 16 * w + fr;
    const float kf = -8.0f * LOG2E * log1pf(expf(-p.lru_lambda[hc])), kb = -8.0f * LOG2E * log1pf(expf(-p.lru_lambda[1024 + hc]));
    const float brf = p.lru_b_r[hc], bif = p.lru_b_i[hc], brb = p.lru_b_r[1024 + hc], bib = p.lru_b_i[1024 + hc];
#pragma unroll
    for (int mb = 0; mb < 4; ++mb)
#pragma unroll
        for (int r = 0; r < 4; ++r) { const float uu = Uf[(16 * mb + 4 * q + r) * 132 + 16 * w + fr];
            const float af = exp2f(kf * sigm(ga[0][mb][r] + brf)), bf_ = sqrtf(fmaxf(1.0f - af * af, 0.0f)) * sigm(ga[1][mb][r] + bif) * uu;
            const float ab = exp2f(kb * sigm(ga[2][mb][r] + brb)), bb_ = sqrtf(fmaxf(1.0f - ab * ab, 0.0f)) * sigm(ga[3][mb][r] + bib) * uu;
            ga[0][mb][r] = af; ga[1][mb][r] = bf_; ga[2][mb][r] = ab; ga[3][mb][r] = bb_; }
    float Af, Bf, Ab, Bb;
    tile_scan<true>(ga[0], ga[1], q, lane, Af, Bf);
    tile_scan<false>(ga[2], ga[3], q, lane, Ab, Bb);
#pragma unroll
    for (int mb = 0; mb < 4; ++mb)
#pragma unroll
        for (int r = 0; r < 4; ++r) { const int off = (16 * mb + 4 * q + r) * 272 + (16 * w + fr) * 2;
            *(LAS bf16_t*)(Ot + off) = f2bf(ga[1][mb][r] + ga[3][mb][r]); *(LAS bf16_t*)(Ot + 17408 + off) = f2bf(ga[0][mb][r]); *(LAS bf16_t*)(Ot + 2 * 17408 + off) = f2bf(ga[2][mb][r]); }
    if (q == 0) { float* carr = (float*)(p.ws + WS_CARR);
        *(f32x2*)(carr + ((size_t)(gt * 2 + 0) * 1024 + hc) * 2) = (f32x2){Af, Bf}; *(f32x2*)(carr + ((size_t)(gt * 2 + 1) * 1024 + hc) * 2) = (f32x2){Ab, Bb}; }
    __syncthreads();
    bf16_t* L = (bf16_t*)p.out;
#pragma unroll
    for (int k = 0; k < 6; ++k) { const int idx = tid + 512 * k, tile = idx >> 10, rem = idx & 1023, row = rem >> 4, chk = rem & 15;
        const u32x4 v = *(const LAS u32x4*)(Ot + tile * 17408 + row * 272 + chk * 16);
        *(u32x4*)(L + (size_t)tile * SLICE_ELEMS + (row0 + row) * 1024 + h * 128 + chk * 8) = v; }
    __syncthreads();
}
__device__ __forceinline__ void lru_pass2_unit(const Params& p, int gt, int half, bf16_t* dry) {
    const int tid = threadIdx.x, c4 = half * 512 + (tid & 127) * 4, rg = tid >> 7;
    const bool prm = gt < 128; const int seq = prm ? (gt >> 2) : 32 + ((gt - 128) >> 5); const int ti = prm ? (gt & 3) : ((gt - 128) & 31); const int nT = prm ? 4 : 32; const int gt0 = gt - ti;
    const float* carr = (const float*)(p.ws + WS_CARR);
    f32x4 hf = (f32x4){0.f, 0.f, 0.f, 0.f}, hb = hf;
    if (!prm) { hf = *(const f32x4*)(p.state_lru + (size_t)((seq - 32) * 2 + 0) * 1024 + c4); hb = *(const f32x4*)(p.state_lru + (size_t)((seq - 32) * 2 + 1) * 1024 + c4); }
    for (int k0 = 0; k0 < ti; k0 += 8) { f32x4 c0[8], c1[8];
#pragma unroll
        for (int j = 0; j < 8; ++j) { const int k = (k0 + j < ti) ? k0 + j : ti - 1; const float* cp = carr + ((size_t)((gt0 + k) * 2 + 0) * 1024 + c4) * 2; c0[j] = *(const f32x4*)cp; c1[j] = *(const f32x4*)(cp + 4); }
#pragma unroll
        for (int j = 0; j < 8; ++j) if (k0 + j < ti) { hf[0] = c0[j][0] * hf[0] + c0[j][1]; hf[1] = c0[j][2] * hf[1] + c0[j][3]; hf[2] = c1[j][0] * hf[2] + c1[j][1]; hf[3] = c1[j][2] * hf[3] + c1[j][3]; } }
    for (int k0 = nT - 1; k0 > ti; k0 -= 8) { f32x4 c0[8], c1[8];
#pragma unroll
        for (int j = 0; j < 8; ++j) { const int k = (k0 - j > ti) ? k0 - j : ti + 1; const float* cp = carr + ((size_t)((gt0 + k) * 2 + 1) * 1024 + c4) * 2; c0[j] = *(const f32x4*)cp; c1[j] = *(const f32x4*)(cp + 4); }
#pragma unroll
        for (int j = 0; j < 8; ++j) if (k0 - j > ti) { hb[0] = c0[j][0] * hb[0] + c0[j][1]; hb[1] = c0[j][2] * hb[1] + c0[j][3]; hb[2] = c1[j][0] * hb[2] + c1[j][1]; hb[3] = c1[j][2] * hb[3] + c1[j][3]; } }
    if (prm && rg == 0) {
        if (ti == nT - 1) { const float* cp = carr + ((size_t)(gt * 2 + 0) * 1024 + c4) * 2; const f32x4 c0 = *(const f32x4*)cp, c1 = *(const f32x4*)(cp + 4);
            *(f32x4*)(p.out + OUT_SLRU + (size_t)(seq * 2 + 0) * 1024 + c4) = (f32x4){c0[0] * hf[0] + c0[1], c0[2] * hf[1] + c0[3], c1[0] * hf[2] + c1[1], c1[2] * hf[3] + c1[3]}; }
        if (ti == 0) { const float* cp = carr + ((size_t)(gt * 2 + 1) * 1024 + c4) * 2; const f32x4 c0 = *(const f32x4*)cp, c1 = *(const f32x4*)(cp + 4);
            *(f32x4*)(p.out + OUT_SLRU + (size_t)(seq * 2 + 1) * 1024 + c4) = (f32x4){c0[0] * hb[0] + c0[1], c0[2] * hb[1] + c0[3], c1[0] * hb[2] + c1[1], c1[2] * hb[3] + c1[3]}; }
    }
    const bf16_t* L = (const bf16_t*)p.out; bf16_t* Pga = (bf16_t*)(p.ws + WS_P) + SLICE_ELEMS;
#pragma unroll 4
    for (int i = 0; i < 16; ++i) { const size_t off = ((size_t)gt * 64 + rg * 16 + i) * 1024 + c4;
        const u32x2 s = *(const u32x2*)(L + off), af = *(const u32x2*)(L + SLICE_ELEMS + off), ab = *(const u32x2*)(L + 2 * SLICE_ELEMS + off), g = *(const u32x2*)(Pga + off);
        const float y0 = (bflo(s.x) + bflo(af.x) * hf[0] + bflo(ab.x) * hb[0]) * silu(bflo(g.x)), y1 = (bfhi(s.x) + bfhi(af.x) * hf[1] + bfhi(ab.x) * hb[1]) * silu(bfhi(g.x));
        const float y2 = (bflo(s.y) + bflo(af.y) * hf[2] + bflo(ab.y) * hb[2]) * silu(bflo(g.y)), y3 = (bfhi(s.y) + bfhi(af.y) * hf[3] + bfhi(ab.y) * hb[3]) * silu(bfhi(g.y));
        u32x2 o; o.x = pk2(y0, y1); o.y = pk2(y2, y3); *(u32x2*)((dry ? dry : Pga) + off) = o; }
}

__device__ __forceinline__ void sconv_unit(const Params& p, int gt, int half) {
    const int tid = threadIdx.x, c4 = half * 512 + (tid & 127) * 4, rg = tid >> 7;
    const int T = gt < 128 ? 256 : 2048, t0 = (gt < 128 ? (gt & 3) : ((gt - 128) & 31)) * 64;
    const bf16_t* P = (const bf16_t*)(p.ws + WS_P); const bf16_t* Pb = P + 2 * SLICE_ELEMS; const bf16_t* Pc = P + 3 * SLICE_ELEMS; const bf16_t* Px = P + 4 * SLICE_ELEMS; bf16_t* Pg = (bf16_t*)(p.ws + WS_P) + 5 * SLICE_ELEMS;
    const f32x4 w0 = *(const f32x4*)(p.sconv_w + c4), w1 = *(const f32x4*)(p.sconv_w + 1024 + c4), w2 = *(const f32x4*)(p.sconv_w + 2048 + c4);
    const int tl0 = rg * 16;
    f32x4 vprev, vcur, vnext;
    auto loadv = [&](int tl) -> f32x4 { const int tt = t0 + tl; if (tt < 0 || tt >= T) return (f32x4){0.f, 0.f, 0.f, 0.f};
        const size_t off = (size_t)((long)gt * 64 + tl) * 1024 + c4; const u32x2 c = *(const u32x2*)(Pc + off), x = *(const u32x2*)(Px + off);
        return (f32x4){bflo(c.x) * bflo(x.x), bfhi(c.x) * bfhi(x.x), bflo(c.y) * bflo(x.y), bfhi(c.y) * bfhi(x.y)}; };
    vprev = loadv(tl0 - 1); vcur = loadv(tl0);
#pragma unroll 4
    for (int i = 0; i < 16; ++i) { const int tl = tl0 + i; vnext = loadv(tl + 1);
        const size_t off = ((size_t)gt * 64 + tl) * 1024 + c4; const u32x2 b = *(const u32x2*)(Pb + off), g = *(const u32x2*)(Pg + off);
        const f32x4 cv = w0 * vprev + w1 * vcur + w2 * vnext;
        u32x2 o; o.x = pk2(bflo(b.x) * cv[0] * silu(bflo(g.x)), bfhi(b.x) * cv[1] * silu(bfhi(g.x))); o.y = pk2(bflo(b.y) * cv[2] * silu(bflo(g.y)), bfhi(b.y) * cv[3] * silu(bfhi(g.y)));
        *(u32x2*)(Pg + off) = o; vprev = vcur; vcur = vnext; }
}

__device__ __forceinline__ void final_norm_phase(const Params& p) {
    const int tid = threadIdx.x, lane = tid & 63, wave = tid >> 6;
    for (int row = blockIdx.x * 8 + wave; row < NTOK; row += gridDim.x * 8) {
        float* xr = p.out + (size_t)row * D; f32x4 v[8]; float ss = 0.f;
#pragma unroll
        for (int j = 0; j < 8; ++j) { v[j] = *(const f32x4*)(xr + 4 * lane + 256 * j); ss += (v[j][0] * v[j][0] + v[j][1] * v[j][1]) + (v[j][2] * v[j][2] + v[j][3] * v[j][3]); }
        const float rstd = 1.0f / sqrtf(wave_sum(ss) * (1.0f / 2048.0f) + EPSV);
#pragma unroll
        for (int j = 0; j < 8; ++j) { const int col = 4 * lane + 256 * j; const f32x4 g = *(const f32x4*)(p.final_norm_g + col); *(f32x4*)(xr + col) = v[j] * rstd * g; }
    }
}


#define XB_TMO      128
#define XB_XCNT(j)  (256  + 64 * (j))
#define XB_XSUB(j)  (1280 + 64 * (j))
#define XB_XGEN(j)  (2304 + 64 * (j))
#define XB_TOP      3328
#define XB_TOPGEN   3392
#define XCD_BAR_WORDS 3456
#define XB_SPIN_CAP (1u << 18)
__device__ __forceinline__ unsigned xb_ld(unsigned* p)              { return __hip_atomic_load(p, __ATOMIC_RELAXED, __HIP_MEMORY_SCOPE_AGENT); }
__device__ __forceinline__ unsigned xb_add(unsigned* p, unsigned v) { return __hip_atomic_fetch_add(p, v, __ATOMIC_RELAXED, __HIP_MEMORY_SCOPE_AGENT); }
__device__ __forceinline__ unsigned xb_xcc_id() { return (unsigned)__builtin_amdgcn_s_getreg((3 << 11) | 20) & 0xFu; }
#define XB_SPIN(cond, bar) do { unsigned _sp = 0; while (cond) { __builtin_amdgcn_s_sleep(1); \
    if ((++_sp & 255u) == 0u) { if (xb_ld(&(bar)[XB_TMO])) break; if (_sp > XB_SPIN_CAP) { atomicAdd(&(bar)[XB_TMO], 1u); break; } } } } while (0)
struct XcdBarrier { unsigned* bar; unsigned x; volatile LAS unsigned* st; };
__device__ __forceinline__ XcdBarrier xcd_barrier_post(unsigned* bar, volatile LAS unsigned* st) {
    XcdBarrier b; b.bar = bar; b.x = xb_xcc_id(); b.st = st;
    if (threadIdx.x == 0) (void)xb_add(&bar[XB_XCNT(b.x)], 1u);
    return b;
}
__device__ __forceinline__ void xcd_barrier_complete(unsigned* bar, unsigned x, unsigned& nloc, unsigned& nx) {
    const unsigned G = gridDim.x * gridDim.y * gridDim.z;
    unsigned sum, cnt, mine, sp = 0u;
    for (;;) {
        sum = 0u; cnt = 0u; mine = 0u;
#pragma unroll
        for (unsigned j = 0; j < 16; ++j) { const unsigned c = xb_ld(&bar[XB_XCNT(j)]); sum += c; cnt += (c > 0u) ? 1u : 0u; mine = (j == x) ? c : mine; }
        if (sum == G) break;
        __builtin_amdgcn_s_sleep(1);
        if ((++sp & 255u) == 0u) { if (xb_ld(&bar[XB_TMO])) break; if (sp > XB_SPIN_CAP) { atomicAdd(&bar[XB_TMO], 1u); break; } }
    }
    nloc = mine > 0u ? mine : 1u; nx = cnt > 0u ? cnt : 1u;
}
__device__ __forceinline__ void xcd_barrier(const XcdBarrier& b) {
    asm volatile("s_waitcnt vmcnt(0)" ::: "memory");
    __syncthreads();
    if (threadIdx.x == 0) {
        unsigned* bar = b.bar;
        __builtin_amdgcn_s_waitcnt(0);
        unsigned nloc = b.st[0], nx = b.st[1];
        if (nloc == 0u) { xcd_barrier_complete(bar, b.x, nloc, nx); b.st[0] = nloc; b.st[1] = nx; }
        const unsigned old = xb_add(&bar[XB_XSUB(b.x)], 1u);
        const unsigned gen = old / nloc;
        if (old + 1u == (gen + 1u) * nloc) {
            __builtin_amdgcn_fence(__ATOMIC_RELEASE, "agent");
            asm volatile("s_waitcnt vmcnt(0)" ::: "memory");
            const unsigned og = xb_add(&bar[XB_TOP], 1u);
            const unsigned tg = og / nx;
            if (og + 1u == (tg + 1u) * nx) xb_add(&bar[XB_TOPGEN], 1u);
            else XB_SPIN(xb_ld(&bar[XB_TOPGEN]) == tg, bar);
            __builtin_amdgcn_fence(__ATOMIC_ACQUIRE, "agent");
            xb_add(&bar[XB_XGEN(b.x)], 1u);
            asm volatile("s_waitcnt vmcnt(0)" ::: "memory");
        } else {
            XB_SPIN(xb_ld(&bar[XB_XGEN(b.x)]) == gen, bar);
            __builtin_amdgcn_fence(__ATOMIC_ACQUIRE, "agent");
            asm volatile("s_waitcnt vmcnt(0)" ::: "memory");
        }
    }
    __syncthreads();
}

constexpr int NPH = 12;
__global__ void __launch_bounds__(512, 2) mk_fwd(Params p) {
    extern __shared__ __attribute__((aligned(16))) unsigned char lds_raw[];
    LAS unsigned char* lds = (LAS unsigned char*)lds_raw;
    const int G = gridDim.x, bid = blockIdx.x;
#define IN(k) (p.ph_lo <= (k) && (k) < p.ph_hi)
    volatile LAS unsigned* MISC = (volatile LAS unsigned*)(lds + LDS_BYTES - 16);
    if (threadIdx.x < 4) MISC[threadIdx.x] = 0u;
    __syncthreads();
    const XcdBarrier xbar = xcd_barrier_post((unsigned*)(p.ws + WS_CTL) + p.li * 4096, MISC);
#define SEAM(k) do { if (IN(k) && IN((k) + 1)) { if ((k) == 0) cg::this_grid().sync(); else xcd_barrier(xbar); } } while (0)
    const char* Hb = (const char*)(p.ws + WS_H);
    bf16_t* Pb = (bf16_t*)(p.ws + WS_P);
    const float* mod = (const float*)(p.ws + WS_MOD);

    if (IN(0)) ph0_prep(p, lds);
    SEAM(0);
    if (IN(1)) normmod_phase(p, p.x_prompt, p.x_sample - (size_t)NPR * D, 0);
    SEAM(1);
    if (IN(2)) { pg8::GCfg g{2048, 2048, 32, 1 << 30, 0l}; pg8::SchedInProj S{Hb, (const char*)(p.ws + WS_WIN), G, bid}; pg8::EpiInProjL0 E{Pb, (const float*)(p.ws + WS_ROPE), (const float*)(p.ws + WS_ROPE) + 2048 * 64};
        pg8::gemm_phase(lds, g, S, E); }
    SEAM(2);
    if (IN(3)) {
        if (!(p.pad & 1)) {
            if (G == 256) {
                if (bid < 128) ret_chain(p, lds, 32 + (bid >> 4), (bid >> 1) & 7, bid & 1);
                else for (int j = 0; j < 4; ++j) { const int cj = (bid - 128) * 4 + j; ret_chain(p, lds, cj >> 4, (cj >> 1) & 7, cj & 1); }
            } else for (int ci = bid; ci < 640; ci += G) { if (ci < 128) ret_chain(p, lds, 32 + (ci >> 4), (ci >> 1) & 7, ci & 1); else { const int cj = ci - 128; ret_chain(p, lds, cj >> 4, (cj >> 1) & 7, cj & 1); } }
        }
        if (!(p.pad & 2)) for (int u = bid; u < 3072; u += G) lru_pass1_unit(p, lds, u >> 3, u & 7);
    }
    SEAM(3);
    if (IN(4)) {
        bf16_t* dry = (p.pad & 16) ? (bf16_t*)p.out + 3 * SLICE_ELEMS : nullptr;
        if (!(p.pad & 4)) for (int u = bid; u < 1536; u += G) ret_out_unit(p, lds, u >> 3, u & 7, dry);
        if (!(p.pad & 8)) for (int u = bid; u < 768; u += G) lru_pass2_unit(p, u >> 1, u & 1, dry);
    }
    SEAM(4);
    if (IN(5)) { pg8::GCfg g{1024, 2048, 32, 16, (long)(4 * SLICE_ELEMS * 2) - 2048l}; pg8::SchedOutProj S{(const char*)(Pb + SLICE_ELEMS), (const char*)(p.ws + WS_WOUT), G, bid};
        pg8::EpiResid E{p.x_prompt, p.x_sample - (size_t)NPR * D, p.out, mod + 4096};
        pg8::gemm_phase(lds, g, S, E); }
    SEAM(5);
    if (IN(6)) normmod_phase(p, p.out, p.out, 1);
    SEAM(6);
    if (IN(7)) { pg8::GCfg g{2048, 2048, 32, 1 << 30, 0l}; pg8::SchedInProj S{Hb, (const char*)(p.ws + WS_WIN) + (size_t)6144 * 2048 * 2, G, bid}; pg8::EpiBf16Store E{Pb, 1024};
        pg8::gemm_phase(lds, g, S, E); }
    SEAM(7);
    if (IN(8)) {
        bf16_t* PQT = (bf16_t*)(p.ws + WS_H);
        { pg8::GCfg g{256, 1024, 4, 1 << 30, 0l}; pg8::SchedF1 S{(const char*)(p.ws + WS_TAB1), (const char*)(Pb + (size_t)NPR * 1024), G, bid, 2048, 8, (long)32 * 1024 * 512}; pg8::EpiBf16Store E{PQT, 4096};
          pg8::gemm_phase(lds, g, S, E); }
        { pg8::GCfg g{256, 1024, 4, 1 << 30, 0l}; pg8::SchedF1 S{(const char*)(p.ws + WS_TAB1), (const char*)Pb, G, bid, 256, 32, 0l}; pg8::EpiBf16Store E{PQT, 512};
          pg8::gemm_phase(lds, g, S, E); }
        for (int u = bid; u < 768; u += G) sconv_unit(p, u >> 1, u & 1);
    }
    SEAM(8);
    if (IN(9)) {
        const char* PQT = (const char*)(p.ws + WS_H);
        { pg8::GCfg g{4096, 4096, 64, 1 << 30, 0l}; pg8::SchedF2 S{(const char*)(p.ws + WS_TAB2S), PQT + (size_t)32 * 1024 * 512 * 2, G, bid, 2048, 8, NPR}; pg8::EpiSiluInPlace E{Pb};
          pg8::gemm_phase(lds, g, S, E); }
        { pg8::GCfg g{512, 512, 8, 1 << 30, 0l}; pg8::SchedF2 S{(const char*)(p.ws + WS_TAB2P), PQT, G, bid, 256, 32, 0}; pg8::EpiSiluInPlace E{Pb};
          pg8::gemm_phase(lds, g, S, E); }
    }
    SEAM(9);
    if (IN(10)) { pg8::GCfg g{1024, 2048, 32, 16, (long)(4 * SLICE_ELEMS * 2) - 2048l}; pg8::SchedOutProj S{(const char*)(Pb + SLICE_ELEMS), (const char*)(p.ws + WS_WOUT) + (size_t)2048 * 2048 * 2, G, bid};
        pg8::EpiResid E{p.out, p.out, p.out, mod + 9 * 6144 + 4096};
        pg8::gemm_phase(lds, g, S, E); }
    SEAM(10);
    if (IN(11)) final_norm_phase(p);
#undef IN
#undef SEAM
}

extern "C" void kernel_launch(void* const* d_in, const int* in_sizes, int n_in, void* d_out, int out_size, void* d_ws, size_t ws_size, hipStream_t stream) {
    static int grid = 0;
    if (grid == 0) {
        int dev = 0, cus = 0, per_cu = 0;
        if (n_in != 22 || ws_size < WS_END) { fprintf(stderr, "kernel_launch: unexpected n_in %d / ws_size %zu (need %zu)\n", n_in, ws_size, (size_t)WS_END); grid = -1; return; }
        (void)hipGetDevice(&dev); (void)hipDeviceGetAttribute(&cus, hipDeviceAttributeMultiprocessorCount, dev);
        if (hipFuncSetAttribute((const void*)mk_fwd, hipFuncAttributeMaxDynamicSharedMemorySize, LDS_BYTES) != hipSuccess) { fprintf(stderr, "kernel_launch: hipFuncSetAttribute failed\n"); grid = -1; return; }
        if (hipOccupancyMaxActiveBlocksPerMultiprocessor(&per_cu, (const void*)mk_fwd, 512, LDS_BYTES) != hipSuccess || per_cu < 1) { fprintf(stderr, "kernel_launch: occupancy query says %d blocks per CU\n", per_cu); (void)hipGetLastError(); per_cu = 1; }
        grid = cus;
        (void)per_cu;
    }
    if (grid < 0) return;
    Params p{};
    const float** pp = (const float**)&p;
    for (int i = 0; i < 22; ++i) pp[i] = (const float*)d_in[i];
    p.out = (float*)d_out; p.ws = (unsigned char*)d_ws;
    if (hipMemsetAsync((char*)d_ws + WS_CTL, 0, 65536, stream) != hipSuccess) { fprintf(stderr, "kernel_launch: hipMemsetAsync failed\n"); return; }
#if MK_PER_PHASE_LAUNCH
    for (int ph = 0; ph < NPH; ++ph) { p.ph_lo = ph; p.ph_hi = ph + 1; hipLaunchKernelGGL(mk_fwd, dim3(grid), dim3(512), LDS_BYTES, stream, p); }
#else
    int plo[3] = {0, 0, 0}, phi[3] = {NPH, 0, 0}, pfl[3] = {0, 0, 0}; int nl = 1;
    if (MK_PROBE >= 100) { nl = 2; phi[0] = MK_PROBE - 100 + 1; plo[1] = MK_PROBE - 100; phi[1] = NPH; }
    if (MK_PROBE == 31 || MK_PROBE == 32) { nl = 2; phi[0] = 4; plo[1] = 3; phi[1] = NPH; pfl[1] = MK_PROBE == 31 ? 2 : 1; }
    if (MK_PROBE == 41 || MK_PROBE == 42) { nl = 3; phi[0] = 4; plo[1] = 4; phi[1] = 5; pfl[1] = 16 | (MK_PROBE == 41 ? 8 : 4); plo[2] = 4; phi[2] = NPH; }
    for (int li = 0; li < nl; ++li) {
        p.ph_lo = plo[li]; p.ph_hi = phi[li]; p.li = li; p.pad = pfl[li];
        void* args[] = {&p};
        hipError_t e = hipLaunchCooperativeKernel((const void*)mk_fwd, dim3(grid), dim3(512), args, LDS_BYTES, stream);
        if (e != hipSuccess) fprintf(stderr, "kernel_launch: cooperative launch failed: %s (grid %d)\n", hipGetErrorString(e), grid);
    }
#endif
}
```

```cpp
#include <hip/hip_runtime.h>
#include <hip/hip_cooperative_groups.h>
#include <cstdio>
namespace cg = cooperative_groups;

#ifndef SKEW_IN
#define SKEW_IN 0
#endif
#ifndef SKEW_OUT
#define SKEW_OUT 0
#endif
#ifndef SKEW_F1
#define SKEW_F1 0
#endif
#ifndef MK_PROBE
#define MK_PROBE -1
#endif
#ifndef MK_PER_PHASE_LAUNCH
#define MK_PER_PHASE_LAUNCH 0
#endif

#define LAS __attribute__((address_space(3)))
typedef unsigned short bf16_t;
typedef short bf16x8 __attribute__((ext_vector_type(8)));
typedef float f32x4 __attribute__((ext_vector_type(4)));
typedef float f32x2 __attribute__((ext_vector_type(2)));
typedef unsigned u32x4 __attribute__((ext_vector_type(4)));
typedef unsigned u32x2 __attribute__((ext_vector_type(2)));

constexpr int D = 2048, WB = 1024, NTOK = 24576, NPR = 8192;
constexpr int LDS_BYTES = 147456;
constexpr float EPSV = 1e-6f;
constexpr float LOG2E = 1.4426950408889634f;
constexpr size_t SLICE_ELEMS = (size_t)NTOK * WB;

constexpr size_t WS_CTL = 0;
constexpr size_t WS_MOD = 65536;
constexpr size_t WS_LRUC = WS_MOD + 458752;
constexpr size_t WS_TW = WS_MOD + 491520;
constexpr size_t WS_WG = WS_MOD + 524288;
constexpr size_t WS_ROPE = WS_WG + (1u << 20);
constexpr size_t WS_TAB1 = WS_ROPE + (1u << 20);
constexpr size_t WS_TAB2P = WS_TAB1 + (256u << 10);
constexpr size_t WS_TAB2S = WS_TAB2P + (256u << 10);
constexpr size_t WS_CARR = WS_TAB2S + (16u << 20);
constexpr size_t WS_WIN = WS_CARR + (6u << 20);
constexpr size_t WS_WOUT = WS_WIN + (48u << 20);
constexpr size_t WS_P = WS_WOUT + (16u << 20);
constexpr size_t WS_H = WS_P + (288ull << 20);
constexpr size_t WS_END = WS_H + (96ull << 20);
constexpr size_t OUT_SLRU = (size_t)NTOK * D;
constexpr size_t OUT_SRET = OUT_SLRU + 65536;

struct Params {
    const float *x_prompt, *x_sample, *state_lru, *state_ret, *c, *c_ctx, *norm_g, *ada_w, *ada_b, *w_in, *w_out,
        *lru_conv_w, *lru_conv_b, *lru_lambda, *lru_w_r, *lru_b_r, *lru_w_i, *lru_b_i, *ret_decay, *ret_norm_g, *sconv_w, *final_norm_g;
    float* out; unsigned char* ws; int ph_lo, ph_hi, li, pad;
};

__device__ __forceinline__ unsigned pk2(float lo, float hi) { unsigned r; asm("v_cvt_pk_bf16_f32 %0, %1, %2" : "=v"(r) : "v"(lo), "v"(hi)); return r; }
__device__ __forceinline__ bf16_t f2bf(float f) { return (bf16_t)(pk2(f, 0.f) & 0xffffu); }
__device__ __forceinline__ float bflo(unsigned u) { return __uint_as_float(u << 16); }
__device__ __forceinline__ float bfhi(unsigned u) { return __uint_as_float(u & 0xffff0000u); }
__device__ __forceinline__ float sigm(float x) { return __builtin_amdgcn_rcpf(1.f + __expf(-x)); }
__device__ __forceinline__ float silu(float x) { return x * sigm(x); }
__device__ __forceinline__ float wave_sum(float v) {
#pragma unroll
    for (int o = 1; o < 64; o <<= 1) v += __shfl_xor(v, o);
    return v;
}
#define LDS_FENCE() asm volatile("s_waitcnt lgkmcnt(0)" ::: "memory")
__device__ __forceinline__ int tid_opaque() { int t = (int)threadIdx.x; asm volatile("" : "+v"(t)); return t; }

namespace pg8 {
constexpr int BM = 256, BK = 64, HALF = 128, HTB = HALF * BK * 2, STAGE_BYTES = 8 * HTB;
__device__ __forceinline__ int lds_byte(int r, int c) { const int st = (r >> 4) * 2 + (c >> 5), rr = r & 15, cc = c & 31, ob = rr * 64 + cc * 2; return st * 1024 + (ob ^ (((ob >> 9) & 1) << 5)); }
__device__ __forceinline__ void stage_rc(int b, int& R, int& C) { const int st = b / 1024, sb = b % 1024, swz = sb ^ (((sb >> 9) & 1) << 5); R = (st >> 1) * 16 + swz / 64; C = (st & 1) * 32 + (swz % 64) / 2; }
__device__ __forceinline__ int perm32(int rho) { const int n = rho >> 4, i = rho & 15; return 8 * (i >> 2) + 4 * n + (i & 3); }

struct GUnit { const char* A; const char* B; long coff; int aux, aux2; };
struct GCfg { int lda, ldb, nt, ksplit; long ksoff; int skew; };

template <bool SP2, class Epi, class Sched, bool ALIGN_EPI = true>
__device__ __forceinline__ void gemm_phase(LAS unsigned char* lds, const GCfg g, const Sched& S, const Epi& E) {
    const int tid = tid_opaque(), wid = __builtin_amdgcn_readfirstlane(tid >> 6), lane = tid & 63, wr = wid >> 2, wc = wid & 3, fr = lane & 15, fq = lane >> 4;
    const int nt = g.nt;
    unsigned voffA[2], voffB[2];
#pragma unroll
    for (int i = 0; i < 2; ++i) { int R, C; stage_rc(tid * 16 + i * 8192, R, C); const int Rb = Epi::PERM ? ((R & ~31) + perm32(R & 31)) : R;
        voffA[i] = (unsigned)(R * g.lda + C) * 2u; voffB[i] = (unsigned)(Rb * g.ldb + C) * 2u; }
    const size_t kstep = (size_t)(BK * 2);
    const size_t hstepA = (size_t)HALF * g.lda * 2, hstepB = (size_t)HALF * g.ldb * 2;
    const unsigned ldsw = (unsigned)wid * 1024u;
    const int aoff = lds_byte(wr * 64 + fr, fq * 8), boff = lds_byte(wc * 32 + fr, fq * 8);
#define PG8_AKT(base, t) ((base) + (size_t)(t) * kstep + ((t) >= g.ksplit ? g.ksoff : 0l))
#define PG8_SA(b, h) (((b) * 2 + (h)) * HTB)
#define PG8_SB(b, h) ((4 + (b) * 2 + (h)) * HTB)
#define PG8_STAGE(bufoff, gbase, voff) do { _Pragma("unroll") for (int _i = 0; _i < 2; ++_i) \
        __builtin_amdgcn_global_load_lds((const unsigned*)((const char*)(gbase) + (voff)[_i]), (LAS unsigned*)(lds + (bufoff) + ldsw + _i * 8192), 16, 0, 0); } while (0)
#define PG8_LDA(dst, b, h) do { _Pragma("unroll") for (int m = 0; m < 4; ++m) _Pragma("unroll") for (int k = 0; k < 2; ++k) dst[m][k] = *(const LAS bf16x8*)(lds + PG8_SA(b, h) + aoff + m * 2048 + k * 1024); } while (0)
#define PG8_LDB(dst, b, h) do { _Pragma("unroll") for (int n = 0; n < 2; ++n) _Pragma("unroll") for (int k = 0; k < 2; ++k) dst[n][k] = *(const LAS bf16x8*)(lds + PG8_SB(b, h) + boff + n * 2048 + k * 1024); } while (0)
#define PG8_MMA(ai, bj, At, Bt) do { __builtin_amdgcn_s_setprio(1); _Pragma("unroll") for (int m = 0; m < 4; ++m) _Pragma("unroll") for (int n = 0; n < 2; ++n) _Pragma("unroll") for (int k = 0; k < 2; ++k) \
        acc[ai][bj][m][n] = __builtin_amdgcn_mfma_f32_16x16x32_bf16(Bt[n][k], At[m][k], acc[ai][bj][m][n], 0, 0, 0); __builtin_amdgcn_s_setprio(0); } while (0)
#define PG8_WAIT_V(n) asm volatile("s_waitcnt vmcnt(" #n ")" ::: "memory")
#define PG8_WAIT_L(n) asm volatile("s_waitcnt lgkmcnt(" #n ")" ::: "memory")
#define PG8_BAR __builtin_amdgcn_s_barrier()
#define PG8_SCHED __builtin_amdgcn_sched_barrier(0)
    GUnit cur, nxt; int ui = 0;
    if (!S.next(0, cur)) return;
    if (g.skew > 0) { const unsigned long long t0 = __builtin_amdgcn_s_memrealtime(); const unsigned long long dt = (unsigned long long)((blockIdx.x & 7) * g.skew);
        while (__builtin_amdgcn_s_memrealtime() - t0 < dt) __builtin_amdgcn_s_sleep(4); }
    f32x4 acc[2][2][4][2];
#pragma unroll
    for (int a = 0; a < 2; ++a)
#pragma unroll
        for (int b = 0; b < 2; ++b)
#pragma unroll
            for (int m = 0; m < 4; ++m)
#pragma unroll
                for (int n = 0; n < 2; ++n) acc[a][b][m][n] = (f32x4){0.f, 0.f, 0.f, 0.f};
    bf16x8 At[4][2], B0[2][2], B1[2][2];
    const char* cA = cur.A; const char* cB = cur.B;
    if constexpr (SP2) {
        PG8_STAGE(PG8_SB(0, 0), cB, voffB); PG8_STAGE(PG8_SB(0, 1), cB + hstepB, voffB); PG8_STAGE(PG8_SA(0, 0), cA, voffA); PG8_STAGE(PG8_SA(0, 1), cA + hstepA, voffA);
        if (wr == 1) PG8_BAR;
        PG8_WAIT_V(2); PG8_BAR;
        PG8_STAGE(PG8_SB(1, 0), cB + kstep, voffB); PG8_STAGE(PG8_SA(1, 0), cA + kstep, voffA); PG8_STAGE(PG8_SB(1, 1), cB + hstepB + kstep, voffB);
        PG8_WAIT_V(6); PG8_BAR;
    } else {
        PG8_STAGE(PG8_SB(0, 0), cB, voffB); PG8_STAGE(PG8_SA(0, 0), cA, voffA); PG8_STAGE(PG8_SB(0, 1), cB + hstepB, voffB); PG8_STAGE(PG8_SA(0, 1), cA + hstepA, voffA);
        if (wr == 1) PG8_BAR;
        PG8_WAIT_V(4); PG8_BAR;
        PG8_STAGE(PG8_SB(1, 0), cB + kstep, voffB); PG8_STAGE(PG8_SA(1, 0), cA + kstep, voffA); PG8_STAGE(PG8_SB(1, 1), cB + hstepB + kstep, voffB);
        PG8_WAIT_V(6); PG8_BAR;
    }
    for (;;) {
        const bool has_next = S.next(ui + 1, nxt);
        const char* nA = has_next ? nxt.A : cA; const char* nB = has_next ? nxt.B : cB;
        for (int t = 0; t < nt; t += 2) {
            const bool last = (t == nt - 2);
            const char* a1 = PG8_AKT(cA, t + 1);
            const char* a2 = last ? nA : PG8_AKT(cA, t + 2); const char* b2 = last ? nB : cB + (size_t)(t + 2) * kstep;
            const char* a3 = a2 + kstep; const char* b3 = b2 + kstep;
            if constexpr (SP2) {
            PG8_LDB(B0, 0, 0); PG8_LDB(B1, 0, 1); PG8_SCHED; PG8_LDA(At, 0, 0); PG8_STAGE(PG8_SA(1, 1), a1 + hstepA, voffA);
            PG8_WAIT_V(8); PG8_WAIT_L(0); PG8_BAR; PG8_MMA(0, 0, At, B0); PG8_MMA(0, 1, At, B1); PG8_BAR; PG8_SCHED;
            PG8_LDA(At, 0, 1); PG8_STAGE(PG8_SB(0, 0), b2, voffB); PG8_STAGE(PG8_SB(0, 1), b2 + hstepB, voffB); PG8_STAGE(PG8_SA(0, 0), a2, voffA);
            PG8_WAIT_V(8); PG8_WAIT_L(0); PG8_BAR; PG8_MMA(1, 0, At, B0); PG8_MMA(1, 1, At, B1); PG8_BAR; PG8_SCHED;
            PG8_LDB(B0, 1, 0); PG8_LDB(B1, 1, 1); PG8_SCHED; PG8_LDA(At, 1, 0); PG8_STAGE(PG8_SA(0, 1), a2 + hstepA, voffA);
            PG8_WAIT_V(8); PG8_WAIT_L(0); PG8_BAR; PG8_MMA(0, 0, At, B0); PG8_MMA(0, 1, At, B1); PG8_BAR; PG8_SCHED;
            PG8_LDA(At, 1, 1); PG8_STAGE(PG8_SB(1, 0), b3, voffB); PG8_STAGE(PG8_SB(1, 1), b3 + hstepB, voffB); PG8_STAGE(PG8_SA(1, 0), a3, voffA);
            PG8_WAIT_V(8); PG8_WAIT_L(0); PG8_BAR; PG8_MMA(1, 0, At, B0); PG8_MMA(1, 1, At, B1); PG8_BAR; PG8_SCHED;
            } else {
            PG8_LDB(B0, 0, 0); PG8_SCHED; PG8_LDA(At, 0, 0); PG8_STAGE(PG8_SA(1, 1), a1 + hstepA, voffA);
            PG8_WAIT_L(8); PG8_BAR; PG8_WAIT_L(0); PG8_MMA(0, 0, At, B0); PG8_BAR; PG8_SCHED;
            PG8_LDB(B1, 0, 1); PG8_STAGE(PG8_SB(0, 0), b2, voffB);
            PG8_BAR; PG8_WAIT_L(0); PG8_MMA(0, 1, At, B1); PG8_BAR;
            PG8_LDA(At, 0, 1); PG8_STAGE(PG8_SA(0, 0), a2, voffA);
            PG8_BAR; PG8_WAIT_L(0); PG8_MMA(1, 0, At, B0); PG8_BAR; PG8_SCHED;
            PG8_STAGE(PG8_SB(0, 1), b2 + hstepB, voffB);
            PG8_WAIT_V(6); PG8_BAR; PG8_MMA(1, 1, At, B1); PG8_BAR;
            PG8_LDB(B0, 1, 0); PG8_SCHED; PG8_LDA(At, 1, 0); PG8_STAGE(PG8_SA(0, 1), a2 + hstepA, voffA);
            PG8_WAIT_L(8); PG8_BAR; PG8_WAIT_L(0); PG8_MMA(0, 0, At, B0); PG8_BAR; PG8_SCHED;
            PG8_LDB(B1, 1, 1); PG8_STAGE(PG8_SB(1, 0), b3, voffB);
            PG8_BAR; PG8_WAIT_L(0); PG8_MMA(0, 1, At, B1); PG8_BAR;
            PG8_LDA(At, 1, 1); PG8_STAGE(PG8_SA(1, 0), a3, voffA);
            PG8_BAR; PG8_WAIT_L(0); PG8_MMA(1, 0, At, B0); PG8_BAR; PG8_SCHED;
            PG8_STAGE(PG8_SB(1, 1), b3 + hstepB, voffB);
            PG8_WAIT_V(6); PG8_BAR; PG8_MMA(1, 1, At, B1); PG8_BAR;
            }
        }
        if constexpr (ALIGN_EPI) { if (wr == 0) PG8_BAR; }
        E(acc, cur, wr, wc, fr, fq);
        if (!has_next) break;
#pragma unroll
        for (int a = 0; a < 2; ++a)
#pragma unroll
            for (int b = 0; b < 2; ++b)
#pragma unroll
                for (int m = 0; m < 4; ++m)
#pragma unroll
                    for (int n = 0; n < 2; ++n) acc[a][b][m][n] = (f32x4){0.f, 0.f, 0.f, 0.f};
        cur = nxt; cA = nA; cB = nB; ++ui;
        if constexpr (ALIGN_EPI) { if (wr == 1) PG8_BAR; }
    }
    PG8_WAIT_V(0);
    if constexpr (!ALIGN_EPI) { if (wr == 0) PG8_BAR; }
    PG8_BAR;
#undef PG8_AKT
#undef PG8_SA
#undef PG8_SB
#undef PG8_STAGE
#undef PG8_LDA
#undef PG8_LDB
#undef PG8_MMA
#undef PG8_WAIT_V
#undef PG8_WAIT_L
#undef PG8_BAR
#undef PG8_SCHED
}

__device__ __forceinline__ bool mn_order(int i, int G, int c, int nM, int nN, int& pm, int& pn) {
    const int nwg = nM * nN; const long L = (long)i * G + c; if (L >= nwg) return false;
    int wgid = (int)L; { const int q = nwg / 8, r = nwg % 8, xcd = wgid % 8, off = wgid / 8; wgid = (xcd < r ? xcd * (q + 1) : r * (q + 1) + (xcd - r) * q) + off; }
    const int nig = 8 * nN, gid = wgid / nig, fm = gid * 8, gsz = (nM - fm) < 8 ? (nM - fm) : 8;
    pm = fm + ((wgid % nig) % gsz); pn = (wgid % nig) / gsz; return true;
}
struct SchedInProj {
    const char* A; const char* B; int G, c; int hot;
    __device__ __forceinline__ bool next(int i, GUnit& u) const { int pm, pn; if (!mn_order(i, G, c, NTOK / 256, 24, pm, pn)) return false;
        u.A = A + (size_t)((hot & 64) ? 0 : pm) * 256 * 2048 * 2; u.B = B + (size_t)((hot & 128) ? 0 : pn) * 256 * 2048 * 2; u.coff = (long)((size_t)(pn >> 2) * SLICE_ELEMS + (size_t)pm * 256 * 1024 + (pn & 3) * 256); u.aux = pn >> 2; const int r0 = pm * 256; u.aux2 = r0 >= NPR ? ((r0 - NPR) & 2047) + 1 : 0; return true; }
};
struct SchedInProjL1 {
    const char* A; const char* B; int G, c;
    __device__ __forceinline__ bool next(int i, GUnit& u) const { int pm, pn; if (!mn_order(i, G, c, NTOK / 256, 24, pm, pn)) return false;
        u.A = A + (size_t)pm * 256 * 2048 * 2; u.B = B + (size_t)pn * 256 * 2048 * 2;
        if (pn < 8) { u.coff = (long)((size_t)(pn >> 2) * SLICE_ELEMS + (size_t)pm * 256 * 1024 + (pn & 3) * 256); u.aux = pn >> 2; u.aux2 = 0; }
        else { u.coff = (long)((size_t)pm * 256 * 1024); u.aux = 2; u.aux2 = (pn - 8) * 64; }
        return true; }
};
struct SchedOutProj {
    const char* A; const char* B; int G, c;
    __device__ __forceinline__ bool next(int i, GUnit& u) const { int pm, pn; if (!mn_order(i, G, c, NTOK / 256, 8, pm, pn)) return false;
        u.A = A + (size_t)pm * 256 * 1024 * 2; u.B = B + (size_t)pn * 256 * 2048 * 2; u.coff = (long)((size_t)pm * 256 * 2048 + pn * 256);
        const int r0 = pm * 256; u.aux = r0 < NPR ? 8 : ((r0 - NPR) >> 11); u.aux2 = r0 >= NPR; return true; }
};
struct SchedF1 {
    const char* Tab1; const char* X0  ; int G, c, T, nb; long pqt0;
    __device__ __forceinline__ bool next(int i, GUnit& u) const { const int ntn = T >> 8; const long L = (long)i * G + c; if (L >= (long)nb * 8 * ntn) return false;
        const int tn = (int)(L % ntn), pm = (int)((L / ntn) & 1), gq = (int)((L / (2 * ntn)) & 3), b = (int)(L / (8 * ntn));
        u.A = Tab1 + (size_t)pm * 256 * 256 * 2; u.B = X0 + ((size_t)(b * T + tn * 256) * 1024 + gq * 256) * 2;
        u.coff = pqt0 + (long)(b * 1024 + gq * 256) * (2 * T) + (long)pm * T + tn * 256; u.aux = 0; u.aux2 = 0; return true; }
};
struct SchedF2 {
    const char* Tab2; const char* WQ; const char* PQTp; int G, c; int lo, hi;
    __device__ __forceinline__ bool next(int i, GUnit& u) const { const long L = lo + (long)i * G + c; if (L >= hi) return false;
        u.A = Tab2; u.aux2 = 0;
        if (L < 256) { const int jt = (int)(L & 3), ka = (int)((L >> 2) & 7), b = (int)(L >> 5);
            u.B = WQ + ((size_t)((b * 8 + ka) * 1024 + jt * 256) * 512) * 2; u.coff = (long)(SLICE_ELEMS + (size_t)(NPR + b * 2048 + ka) * 1024 + jt * 256); u.aux = 8 * 1024; }
        else { const int Lp = (int)(L - 256), pn = Lp & 3, b = Lp >> 2;
            u.B = PQTp + ((size_t)(b * 1024 + pn * 256) * 512) * 2; u.coff = (long)(SLICE_ELEMS + (size_t)(b * 256) * 1024 + pn * 256); u.aux = 1024; }
        return true; }
};

struct EpiBf16Store {
    static constexpr bool PERM = true;
    bf16_t* O; int ldc;
    __device__ __forceinline__ void operator()(const f32x4 (&acc)[2][2][4][2], const GUnit& u, int wr, int wc, int fr, int fq) const {
        bf16_t* base = O + u.coff + (size_t)(wr * 64 + fr) * ldc + wc * 32 + 8 * fq;
#pragma unroll
        for (int ai = 0; ai < 2; ++ai)
#pragma unroll
            for (int m = 0; m < 4; ++m) { bf16_t* rowp = base + (size_t)(ai * HALF + m * 16) * ldc;
#pragma unroll
                for (int bj = 0; bj < 2; ++bj) { const f32x4 v0 = acc[ai][bj][m][0], v1 = acc[ai][bj][m][1];
                    u32x4 w; w.x = pk2(v0[0], v0[1]); w.y = pk2(v0[2], v0[3]); w.z = pk2(v1[0], v1[1]); w.w = pk2(v1[2], v1[3]);
                    *(u32x4*)(rowp + bj * HALF) = w; } }
    }
};
struct EpiInProjL0 {
    static constexpr bool PERM = true;
    bf16_t* O; const float* ropeC; const float* ropeS; int nostore;
    __device__ __forceinline__ void operator()(const f32x4 (&acc)[2][2][4][2], const GUnit& u, int wr, int wc, int fr, int fq) const {
        bf16_t* base = O + u.coff + (size_t)(wr * 64 + fr) * 1024 + wc * 32 + 8 * fq;
        const bool qk = (u.aux == 2 || u.aux == 3), rope = qk && u.aux2 > 0; const float scl = u.aux == 3 ? 0.08838834764831845f : 1.0f;
        const int f0 = 16 * wc + 4 * fq;
#pragma unroll
        for (int ai = 0; ai < 2; ++ai)
#pragma unroll
            for (int m = 0; m < 4; ++m) { bf16_t* rowp = base + (size_t)(ai * HALF + m * 16) * 1024;
                f32x4 cs = (f32x4){1.f, 1.f, 1.f, 1.f}, sn = (f32x4){0.f, 0.f, 0.f, 0.f};
                if (rope) { const int t = (u.aux2 - 1) + ai * HALF + wr * 64 + m * 16 + fr; cs = *(const f32x4*)(ropeC + t * 64 + f0); sn = *(const f32x4*)(ropeS + t * 64 + f0); }
#pragma unroll
                for (int bj = 0; bj < 2; ++bj) { f32x4 v0 = acc[ai][bj][m][0], v1 = acc[ai][bj][m][1];
                    if (qk) { const f32x4 a0 = v0, a1 = v1;
                        v0[0] = (a0[0] * cs[0] - a0[1] * sn[0]) * scl; v0[1] = (a0[0] * sn[0] + a0[1] * cs[0]) * scl; v0[2] = (a0[2] * cs[1] - a0[3] * sn[1]) * scl; v0[3] = (a0[2] * sn[1] + a0[3] * cs[1]) * scl;
                        v1[0] = (a1[0] * cs[2] - a1[1] * sn[2]) * scl; v1[1] = (a1[0] * sn[2] + a1[1] * cs[2]) * scl; v1[2] = (a1[2] * cs[3] - a1[3] * sn[3]) * scl; v1[3] = (a1[2] * sn[3] + a1[3] * cs[3]) * scl; }
                    u32x4 w; w.x = pk2(v0[0], v0[1]); w.y = pk2(v0[2], v0[3]); w.z = pk2(v1[0], v1[1]); w.w = pk2(v1[2], v1[3]);
                    if (!(nostore & 32) && !((nostore & 256) && bj == 1) || (w.x == 0x12345678u && w.y == 0x9abcdef0u)) *(u32x4*)(rowp + bj * HALF) = w; } }
    }
};
struct EpiInProjL1 {
    static constexpr bool PERM = true;
    bf16_t* O;
    __device__ __forceinline__ void operator()(const f32x4 (&acc)[2][2][4][2], const GUnit& u, int wr, int wc, int fr, int fq) const {
        if (u.aux < 2) {
            bf16_t* base = O + u.coff + (size_t)(wr * 64 + fr) * 1024 + wc * 32 + 8 * fq;
#pragma unroll
            for (int ai = 0; ai < 2; ++ai)
#pragma unroll
                for (int m = 0; m < 4; ++m) { bf16_t* rowp = base + (size_t)(ai * HALF + m * 16) * 1024;
#pragma unroll
                    for (int bj = 0; bj < 2; ++bj) { const f32x4 v0 = acc[ai][bj][m][0], v1 = acc[ai][bj][m][1];
                        u32x4 w; w.x = pk2(v0[0], v0[1]); w.y = pk2(v0[2], v0[3]); w.z = pk2(v1[0], v1[1]); w.w = pk2(v1[2], v1[3]);
                        *(u32x4*)(rowp + bj * HALF) = w; } }
        } else {
            bf16_t* obase = O + (size_t)(2 + (fq & 1)) * SLICE_ELEMS + u.coff + (size_t)(wr * 64 + fr) * 1024 + u.aux2 + 32 * (fq >> 1) + 8 * wc;
            const bool odd = (fq & 1) != 0, hi = (fq & 2) != 0;
#pragma unroll
            for (int ai = 0; ai < 2; ++ai)
#pragma unroll
                for (int m = 0; m < 4; ++m) {
                    unsigned x[4];
#pragma unroll
                    for (int bj = 0; bj < 2; ++bj) { const f32x4 a = acc[ai][bj][m][0], b = acc[ai][bj][m][1];
                        x[2 * bj] = pk2(a[1] * a[2], b[1] * b[2]); x[2 * bj + 1] = pk2(a[0] * silu(a[3]), b[0] * silu(b[3])); }
                    const unsigned sA0 = odd ? x[0] : x[1], sA1 = odd ? x[2] : x[3];
                    const unsigned rA0 = (unsigned)__shfl_xor((int)sA0, 16), rA1 = (unsigned)__shfl_xor((int)sA1, 16);
                    const unsigned a0 = odd ? rA0 : x[0], a1 = odd ? x[1] : rA0, a2 = odd ? rA1 : x[2], a3 = odd ? x[3] : rA1;
                    const unsigned sB0 = hi ? a0 : a2, sB1 = hi ? a1 : a3;
                    const unsigned rB0 = (unsigned)__shfl_xor((int)sB0, 32), rB1 = (unsigned)__shfl_xor((int)sB1, 32);
                    u32x4 y; y.x = hi ? rB0 : a0; y.y = hi ? rB1 : a1; y.z = hi ? a2 : rB0; y.w = hi ? a3 : rB1;
                    *(u32x4*)(obase + (size_t)(ai * HALF + m * 16) * 1024) = y; }
        }
    }
};
struct EpiSiluInPlace {
    static constexpr bool PERM = true;
    bf16_t* O;
    __device__ __forceinline__ void operator()(const f32x4 (&acc)[2][2][4][2], const GUnit& u, int wr, int wc, int fr, int fq) const {
        const size_t ldc = (size_t)u.aux;
        bf16_t* base = O + u.coff + (size_t)(wr * 64 + fr) * ldc + wc * 32 + 8 * fq;
#pragma unroll
        for (int ai = 0; ai < 2; ++ai)
#pragma unroll
            for (int m = 0; m < 4; ++m) { bf16_t* rowp = base + (size_t)(ai * HALF + m * 16) * ldc;
#pragma unroll
                for (int bj = 0; bj < 2; ++bj) { const f32x4 v0 = acc[ai][bj][m][0], v1 = acc[ai][bj][m][1];
                    const u32x4 gv = *(const u32x4*)(rowp + bj * HALF);
                    u32x4 w; w.x = pk2(v0[0] * silu(bflo(gv.x)), v0[1] * silu(bfhi(gv.x))); w.y = pk2(v0[2] * silu(bflo(gv.y)), v0[3] * silu(bfhi(gv.y)));
                    w.z = pk2(v1[0] * silu(bflo(gv.z)), v1[1] * silu(bfhi(gv.z))); w.w = pk2(v1[2] * silu(bflo(gv.w)), v1[3] * silu(bfhi(gv.w)));
                    *(u32x4*)(rowp + bj * HALF) = w; } }
    }
};
struct EpiResid {
    static constexpr bool PERM = false;
    const float* xin0; const float* xin1; float* out; const float* gate;
    __device__ __forceinline__ void operator()(const f32x4 (&acc)[2][2][4][2], const GUnit& u, int wr, int wc, int fr, int fq) const {
        const size_t off0 = (size_t)u.coff + (size_t)(wr * 64 + fr) * 2048 + wc * 32 + 4 * fq;
        const int col0 = (int)(u.coff & 2047) + wc * 32 + 4 * fq;
        const float* xb = u.aux2 ? xin1 : xin0; const float* gp = gate + (size_t)u.aux * 6144 + col0;
        f32x4 gv[2][2];
#pragma unroll
        for (int bj = 0; bj < 2; ++bj)
#pragma unroll
            for (int n = 0; n < 2; ++n) gv[bj][n] = *(const f32x4*)(gp + bj * HALF + n * 16);
#pragma unroll
        for (int ai = 0; ai < 2; ++ai)
#pragma unroll
            for (int m = 0; m < 4; ++m) { const size_t off = off0 + (size_t)(ai * HALF + m * 16) * 2048;
#pragma unroll
                for (int bj = 0; bj < 2; ++bj)
#pragma unroll
                    for (int n = 0; n < 2; ++n) { const f32x4 xv = *(const f32x4*)(xb + off + bj * HALF + n * 16);
                        *(f32x4*)(out + off + bj * HALF + n * 16) = xv + gv[bj][n] * acc[ai][bj][m][n]; } }
    }
};
template <bool XBF>
struct EpiResidB {
    static constexpr bool PERM = true;
    const void* xin0; const void* xin1; bf16_t* xout; const float* gate;
    __device__ __forceinline__ void operator()(const f32x4 (&acc)[2][2][4][2], const GUnit& u, int wr, int wc, int fr, int fq) const {
        const size_t off0 = (size_t)u.coff + (size_t)(wr * 64 + fr) * 2048 + wc * 32 + 8 * fq;
        const int col0 = (int)(u.coff & 2047) + wc * 32 + 8 * fq;
        const void* xb = u.aux2 ? xin1 : xin0; const float* gp = gate + (size_t)u.aux * 6144 + col0;
        f32x4 gv[2][2];
#pragma unroll
        for (int bj = 0; bj < 2; ++bj)
#pragma unroll
            for (int n = 0; n < 2; ++n) gv[bj][n] = *(const f32x4*)(gp + bj * HALF + n * 4);
#pragma unroll
        for (int ai = 0; ai < 2; ++ai) {
            if (XBF) { u32x4 xv[4][2];
#pragma unroll
                for (int m = 0; m < 4; ++m)
#pragma unroll
                    for (int bj = 0; bj < 2; ++bj) xv[m][bj] = *(const u32x4*)((const bf16_t*)xb + off0 + (size_t)(ai * HALF + m * 16) * 2048 + bj * HALF);
#pragma unroll
                for (int m = 0; m < 4; ++m)
#pragma unroll
                    for (int bj = 0; bj < 2; ++bj) { const u32x4 x = xv[m][bj]; const f32x4 x0 = (f32x4){bflo(x.x), bfhi(x.x), bflo(x.y), bfhi(x.y)}, x1 = (f32x4){bflo(x.z), bfhi(x.z), bflo(x.w), bfhi(x.w)};
                        const f32x4 y0 = x0 + gv[bj][0] * acc[ai][bj][m][0], y1 = x1 + gv[bj][1] * acc[ai][bj][m][1];
                        u32x4 w; w.x = pk2(y0[0], y0[1]); w.y = pk2(y0[2], y0[3]); w.z = pk2(y1[0], y1[1]); w.w = pk2(y1[2], y1[3]);
                        *(u32x4*)(xout + off0 + (size_t)(ai * HALF + m * 16) * 2048 + bj * HALF) = w; } }
            else { f32x4 xv[4][2][2];
#pragma unroll
                for (int m = 0; m < 4; ++m)
#pragma unroll
                    for (int bj = 0; bj < 2; ++bj) { const float* xp = (const float*)xb + off0 + (size_t)(ai * HALF + m * 16) * 2048 + bj * HALF; xv[m][bj][0] = *(const f32x4*)xp; xv[m][bj][1] = *(const f32x4*)(xp + 4); }
#pragma unroll
                for (int m = 0; m < 4; ++m)
#pragma unroll
                    for (int bj = 0; bj < 2; ++bj) { const f32x4 y0 = xv[m][bj][0] + gv[bj][0] * acc[ai][bj][m][0], y1 = xv[m][bj][1] + gv[bj][1] * acc[ai][bj][m][1];
                        u32x4 w; w.x = pk2(y0[0], y0[1]); w.y = pk2(y0[2], y0[3]); w.z = pk2(y1[0], y1[1]); w.w = pk2(y1[2], y1[3]);
                        *(u32x4*)(xout + off0 + (size_t)(ai * HALF + m * 16) * 2048 + bj * HALF) = w; } }
            __builtin_amdgcn_sched_barrier(0);
        }
    }
};
}

__device__ __forceinline__ void mod_unit(const Params& p, LAS unsigned char* lds, int u) {
    const int tid = tid_opaque(), lane = tid & 63, wave = tid >> 6;
    LAS float* scond = (LAS float*)lds;
    for (int i = tid; i < 9 * 2048; i += 512) { const int ci = i >> 11, k = i & 2047; const float v = ci < 8 ? p.c[ci * 2048 + k] : p.c_ctx[k]; scond[i] = silu(v); }
    __syncthreads();
    const int l = u / 48, n0 = (u % 48) * 128, ct = lane & 31, rg = 2 * wave + (lane >> 5);
    const float* Wp = p.ada_w + (size_t)l * 2048 * 6144 + n0 + ct * 4;
    float acc[9][4];
#pragma unroll
    for (int ci = 0; ci < 9; ++ci)
#pragma unroll
        for (int j = 0; j < 4; ++j) acc[ci][j] = 0.f;
#pragma unroll 8
    for (int k = rg; k < 2048; k += 16) {
        const f32x4 w = *(const f32x4*)(Wp + (size_t)k * 6144);
#pragma unroll
        for (int ci = 0; ci < 9; ++ci) { const float s = scond[ci * 2048 + k]; acc[ci][0] += s * w[0]; acc[ci][1] += s * w[1]; acc[ci][2] += s * w[2]; acc[ci][3] += s * w[3]; }
    }
#pragma unroll
    for (int ci = 0; ci < 9; ++ci)
#pragma unroll
        for (int j = 0; j < 4; ++j) acc[ci][j] += __shfl_xor(acc[ci][j], 32);
    __syncthreads();
    LAS float* red = (LAS float*)lds;
    if (lane < 32) {
#pragma unroll
        for (int ci = 0; ci < 9; ++ci)
#pragma unroll
            for (int j = 0; j < 4; ++j) red[(wave * 32 + ct) * 36 + ci * 4 + j] = acc[ci][j];
    }
    __syncthreads();
    float* mod = (float*)(p.ws + WS_MOD);
    for (int o = tid; o < 9 * 128; o += 512) { const int ci = o >> 7, col = o & 127, ct2 = col >> 2, j = col & 3; float s = 0.f;
#pragma unroll
        for (int w = 0; w < 8; ++w) s += red[(w * 32 + ct2) * 36 + ci * 4 + j];
        mod[(size_t)(l * 9 + ci) * 6144 + n0 + col] = s + p.ada_b[l * 6144 + n0 + col]; }
    __syncthreads();
}
__device__ __forceinline__ int qk_perm_row(int n) { return (n >= 2048 && n < 4096) ? ((n & ~127) | ((n & 63) << 1) | ((n >> 6) & 1)) : n; }
__device__ __forceinline__ int l1_perm_row(int n) { return n >= 2048 ? 2048 + 4 * (n & 1023) + ((n >> 10) - 2) : n; }
__device__ __forceinline__ void transpose_item(const float* Wm, int K, int N, bf16_t* WT, LAS float* scr, int item, int lane, int perm  ) {
    const int nblk = N / 64, kb = item / nblk, nb = item % nblk, k0 = 64 * kb, n0 = 64 * nb;
    { const int r4 = lane >> 4, c16 = lane & 15; f32x4 v[16];
#pragma unroll
      for (int i = 0; i < 16; ++i) v[i] = *(const f32x4*)(Wm + (size_t)(k0 + 4 * i + r4) * N + n0 + 4 * c16);
#pragma unroll
      for (int i = 0; i < 16; ++i) { LAS float* d = scr + (4 * i + r4) * 65 + 4 * c16; d[0] = v[i][0]; d[1] = v[i][1]; d[2] = v[i][2]; d[3] = v[i][3]; } }
    LDS_FENCE();
    const int cc = lane & 7;
#pragma unroll
    for (int j = 0; j < 8; ++j) { const int n = (lane >> 3) + 8 * j; const LAS float* s = scr + (8 * cc) * 65 + n;
        u32x4 o; o.x = pk2(s[0 * 65], s[1 * 65]); o.y = pk2(s[2 * 65], s[3 * 65]); o.z = pk2(s[4 * 65], s[5 * 65]); o.w = pk2(s[6 * 65], s[7 * 65]);
        const int nr = perm == 1 ? qk_perm_row(n0 + n) : (perm == 2 ? l1_perm_row(n0 + n) : n0 + n);
        *(u32x4*)(WT + (size_t)nr * K + k0 + 8 * cc) = o; }
    LDS_FENCE();
}
__device__ __forceinline__ void ph0_prep(const Params& p, LAS unsigned char* lds) {
    const int tid = tid_opaque(), lane = tid & 63, wave = tid >> 6, G = gridDim.x, bid = blockIdx.x;
    for (int u = bid; u < 96; u += G) mod_unit(p, lds, u);
    { LAS float* scr = (LAS float*)(lds + wave * 16640);
      const int gw = bid * 8 + wave, NGW = G * 8;
      bf16_t* WinT = (bf16_t*)(p.ws + WS_WIN); bf16_t* WoutT = (bf16_t*)(p.ws + WS_WOUT);
      constexpr int I_IN = 32 * 96, I_OUT = 32 * 32;
      for (int it = gw; it < I_IN + I_OUT; it += NGW) {
          if (it < I_IN) transpose_item(p.w_in, 2048, 6144, WinT, scr, it, lane, 1);
          else transpose_item(p.w_out, 2048, 2048, WoutT, scr, it - I_IN, lane, 0);
      } }
    const int gt = bid * 512 + tid, NT = G * 512;
    { bf16_t* Wg = (bf16_t*)(p.ws + WS_WG);
      for (int idx = gt; idx < 8 * 512 * 128; idx += NT) { const int i = idx & 127, n = (idx >> 7) & 511, h = idx >> 16, g = n >> 7, j = n & 127;
          const float* src = (g & 1) ? p.lru_w_i : p.lru_w_r; const int dir = g >> 1;
          Wg[idx] = f2bf(src[((size_t)(dir * 8 + h) * 128 + i) * 128 + j]); } }
    { float* lc = (float*)(p.ws + WS_LRUC);
      for (int c = gt; c < 1024; c += NT) { f32x4 a, b; a[0] = -8.0f * LOG2E * log1pf(expf(-p.lru_lambda[c])); a[1] = -8.0f * LOG2E * log1pf(expf(-p.lru_lambda[1024 + c])); a[2] = p.lru_b_r[c]; a[3] = p.lru_b_i[c];
          b[0] = p.lru_b_r[1024 + c]; b[1] = p.lru_b_i[1024 + c]; b[2] = 0.f; b[3] = 0.f; *(f32x4*)(lc + c * 8) = a; *(f32x4*)(lc + c * 8 + 4) = b; } }
    { float* rc = (float*)(p.ws + WS_ROPE); float* rs = rc + 2048 * 64;
      for (int idx = gt; idx < 2048 * 64; idx += NT) { const int f = idx & 63, t = idx >> 6; const float pos = (f < 32) ? (float)(t >> 6) : (float)(t & 63);
          const float fr = powf(10000.0f, -(float)(f & 31) / 32.0f); const float ang = pos * fr; rc[idx] = cosf(ang); rs[idx] = sinf(ang); } }
}
__device__ __forceinline__ void prep_layer1(const Params& p, LAS unsigned char* lds) {
    const int tid = tid_opaque(), lane = tid & 63, wave = tid >> 6, G = gridDim.x, bid = blockIdx.x;
    { LAS float* scr = (LAS float*)(lds + wave * 16640);
      const int gw = bid * 8 + wave, NGW = G * 8;
      bf16_t* WinT = (bf16_t*)(p.ws + WS_WIN) + (size_t)6144 * 2048; bf16_t* WoutT = (bf16_t*)(p.ws + WS_WOUT) + (size_t)2048 * 2048;
      constexpr int I_IN = 32 * 96, I_OUT = 32 * 32;
      for (int it = gw; it < I_IN + I_OUT; it += NGW) {
          if (it < I_IN) transpose_item(p.w_in + (size_t)2048 * 6144, 2048, 6144, WinT, scr, it, lane, 2);
          else transpose_item(p.w_out + (size_t)2048 * 2048, 2048, 2048, WoutT, scr, it - I_IN, lane, 0);
      } }
    const int gt = bid * 512 + tid, NT = G * 512;
    { bf16_t* T1 = (bf16_t*)(p.ws + WS_TAB1);
      for (int i8 = gt; i8 < 512 * 256 / 8; i8 += NT) { const int j = (i8 * 8) >> 8, c0 = (i8 * 8) & 255; float v[8];
#pragma unroll
          for (int e = 0; e < 8; ++e) { const int m = ((j & 255) * (c0 + e)) & 255; const float a = (float)m * (2.0f / 256.0f); v[e] = (j < 256 ? cospif(a) : sinpif(a)) * 0.0625f; }
          u32x4 o; o.x = pk2(v[0], v[1]); o.y = pk2(v[2], v[3]); o.z = pk2(v[4], v[5]); o.w = pk2(v[6], v[7]); *(u32x4*)(T1 + (size_t)i8 * 8) = o; } }
    { bf16_t* T2 = (bf16_t*)(p.ws + WS_TAB2P);
      for (int i8 = gt; i8 < 256 * 512 / 8; i8 += NT) { const int k1 = (i8 * 8) >> 9, c0 = (i8 * 8) & 511; float v[8];
#pragma unroll
          for (int e = 0; e < 8; ++e) { const int col = c0 + e, t = col & 255; const int m = (k1 * t) & 255; const float a = (float)m * (2.0f / 256.0f);
              v[e] = (col < 256 ? cospif(a) : -sinpif(a)) * 0.0625f; }
          u32x4 o; o.x = pk2(v[0], v[1]); o.y = pk2(v[2], v[3]); o.z = pk2(v[4], v[5]); o.w = pk2(v[6], v[7]); *(u32x4*)(T2 + (size_t)i8 * 8) = o; } }
    { float* tw = (float*)(p.ws + WS_TW);
      for (int i = gt; i < 8 * 256; i += NT) { const int ka = i >> 8, tlo = i & 255; const float a = (float)(ka * tlo) * (1.0f / 1024.0f); tw[i] = cospif(a); tw[2048 + i] = sinpif(a); } }
    __syncthreads();
}

template <bool XBF>
__device__ __forceinline__ void normmod_phase(const Params& p, const void* x0, const void* x1  , int l, bf16_t* H) {
    const int tid = tid_opaque(), lane = tid & 63, wave = tid >> 6;
    const float* mod = (const float*)(p.ws + WS_MOD) + (size_t)l * 9 * 6144; const float* ng = p.norm_g + l * 2048;
    const int nw = gridDim.x * 8, gw = blockIdx.x * 8 + wave, per = (NTOK + nw - 1) / nw, r0 = gw * per, r1 = (r0 + per < NTOK) ? r0 + per : NTOK;
    f32x4 av[8], sv[8]; int cic = -1;
    for (int row = r0; row < r1; ++row) {
        const int ci = row < NPR ? 8 : ((row - NPR) >> 11);
        if (ci != cic) { cic = ci; const float* sh = mod + (size_t)ci * 6144; const float* sc = sh + 2048;
#pragma unroll
            for (int j = 0; j < 8; ++j) { const int col = 8 * lane + 512 * (j >> 1) + 4 * (j & 1); av[j] = *(const f32x4*)(ng + col) * (1.0f + *(const f32x4*)(sc + col)); sv[j] = *(const f32x4*)(sh + col); } }
        f32x4 v[8]; float ss = 0.f;
        if (XBF) { const bf16_t* xr = (const bf16_t*)(row < NPR ? x0 : x1) + (size_t)row * D;
#pragma unroll
            for (int j = 0; j < 4; ++j) { const u32x4 xv = *(const u32x4*)(xr + 8 * lane + 512 * j); v[2 * j] = (f32x4){bflo(xv.x), bfhi(xv.x), bflo(xv.y), bfhi(xv.y)}; v[2 * j + 1] = (f32x4){bflo(xv.z), bfhi(xv.z), bflo(xv.w), bfhi(xv.w)}; } }
        else { const float* xr = (const float*)(row < NPR ? x0 : x1) + (size_t)row * D;
#pragma unroll
            for (int j = 0; j < 4; ++j) { v[2 * j] = *(const f32x4*)(xr + 8 * lane + 512 * j); v[2 * j + 1] = *(const f32x4*)(xr + 8 * lane + 512 * j + 4); } }
#pragma unroll
        for (int j = 0; j < 8; ++j) ss += (v[j][0] * v[j][0] + v[j][1] * v[j][1]) + (v[j][2] * v[j][2] + v[j][3] * v[j][3]);
        const float rstd = 1.0f / sqrtf(wave_sum(ss) * (1.0f / 2048.0f) + EPSV);
#pragma unroll
        for (int j = 0; j < 4; ++j) { const int col = 8 * lane + 512 * j;
            const f32x4 h0 = (v[2 * j] * rstd) * av[2 * j] + sv[2 * j], h1 = (v[2 * j + 1] * rstd) * av[2 * j + 1] + sv[2 * j + 1];
            u32x4 o; o.x = pk2(h0[0], h0[1]); o.y = pk2(h0[2], h0[3]); o.z = pk2(h1[0], h1[1]); o.w = pk2(h1[2], h1[3]); *(u32x4*)(H + (size_t)row * D + col) = o; }
    }
}

typedef short s16x4 __attribute__((ext_vector_type(4)));
__device__ __forceinline__ unsigned off_b(unsigned row, unsigned ch) { return 256u * row + 16u * (ch ^ (((row & 3u) << 2) | ((row >> 2) & 3u))); }
__device__ __forceinline__ bf16x8 row_frag(LAS unsigned char* T, int rb, int s, int lane) { return *(const LAS bf16x8*)(T + off_b((unsigned)((lane & 15) + 16 * rb), (unsigned)(4 * s + (lane >> 4)))); }
__device__ __forceinline__ bf16x8 row_frag_p(LAS unsigned char* T, int rb, int s, int lane) { return *(const LAS bf16x8*)(T + ((lane & 15) + 16 * rb) * 272 + (4 * s + (lane >> 4)) * 16); }
__device__ __forceinline__ bf16x8 tr_frag(LAS unsigned char* T, int r0, int r1, int c, int lane) {
    const unsigned qq = (unsigned)(lane & 15) >> 2, pp = (unsigned)lane & 3u;
    const s16x4 x = __builtin_amdgcn_ds_read_tr16_b64_v4i16((LAS s16x4*)(T + off_b((unsigned)r0 + qq, 2u * (unsigned)c + (pp >> 1)) + 8u * (pp & 1u)));
    const s16x4 y = __builtin_amdgcn_ds_read_tr16_b64_v4i16((LAS s16x4*)(T + off_b((unsigned)r1 + qq, 2u * (unsigned)c + (pp >> 1)) + 8u * (pp & 1u)));
    return (bf16x8){x[0], x[1], x[2], x[3], y[0], y[1], y[2], y[3]};
}
__device__ __forceinline__ int ret_slot(int seq, int h, int dir, int ch) { return seq < 32 ? (((seq * 8 + h) * 2 + dir) * 2 + ch) : (1024 + ((((seq - 32) * 8 + h) * 2 + dir) * 16 + ch)); }

__device__ __forceinline__ void ret_chain_stream(const Params& p, LAS unsigned char* lds, int id0, int nchains) {
    const int tid = tid_opaque(), lane = tid & 63, w = tid >> 6, q = lane >> 4, fr = lane & 15;
    const bool smp = id0 < 128; const int nch = smp ? 16 : 2, lgn = smp ? 4 : 1, nsteps = nchains * nch;
    const bf16_t* Pk = (const bf16_t*)(p.ws + WS_P) + 3 * SLICE_ELEMS; const bf16_t* Pv = (const bf16_t*)(p.ws + WS_P) + 4 * SLICE_ELEMS;
    bf16_t* Sbuf = (bf16_t*)(p.ws + WS_H);
    f32x4 acc[8];
    float lg2 = 0.f, cd = 1.f;
    u32x4 kA[4], vA[4], kB[4], vB[4];
#define RET_DECODE(s, seq_, h_, dir_, ch_) const int cid_ = id0 + ((s) >> lgn), cj_ = smp ? cid_ : cid_ - 128; const int seq_ = (smp ? 32 : 0) + (cj_ >> 4), h_ = (cj_ >> 1) & 7, dir_ = cj_ & 1; const int st_ = (s) & (nch - 1); const int ch_ = dir_ ? nch - 1 - st_ : st_;
#define RET_ISSUE(s, kR, vR) do { if ((s) < nsteps) { RET_DECODE(s, sq, hh, dd, cc) const int rb_ = smp ? NPR + (sq - 32) * 2048 : sq * 256; \
        _Pragma("unroll") for (int rep = 0; rep < 4; ++rep) { const int it = tid + 512 * rep, chk = it & 15, row = it >> 4; const size_t go = (size_t)(rb_ + cc * 128 + row) * 1024 + hh * 128 + chk * 8; \
            kR[rep] = *(const u32x4*)(Pk + go); vR[rep] = *(const u32x4*)(Pv + go); } } } while (0)
#define RET_STEP(s, kR, vR) do { RET_DECODE(s, seq, h, dir, ch) \
        if (((s) & (nch - 1)) == 0) {   \
            lg2 = -log1pf(expf(-p.ret_decay[dir * 8 + h])) * LOG2E; cd = __builtin_amdgcn_exp2f(lg2 * 128.0f); \
            if (smp) { const float* S0 = p.state_ret + (size_t)(((seq - 32) * 2 + dir) * 8 + h) * 16384; \
                _Pragma("unroll") for (int nb = 0; nb < 8; ++nb) _Pragma("unroll") for (int r = 0; r < 4; ++r) { const int dp = 16 * w + 4 * q + r, d = ((dp & 1) << 6) | (dp >> 1); acc[nb][r] = S0[d * 128 + 16 * nb + fr]; } } \
            else { _Pragma("unroll") for (int nb = 0; nb < 8; ++nb) acc[nb] = (f32x4){0.f, 0.f, 0.f, 0.f}; } } \
        { bf16_t* Sd = Sbuf + (size_t)ret_slot(seq, h, dir, ch) * 16384;        \
          _Pragma("unroll") for (int nb = 0; nb < 8; ++nb) { u32x2 v; v.x = pk2(acc[nb][0], acc[nb][1]); v.y = pk2(acc[nb][2], acc[nb][3]); *(u32x2*)(Sd + (16 * nb + fr) * 128 + 16 * w + 4 * q) = v; } } \
        LAS unsigned char* Kb = lds + ((s) & 1) * 65536; LAS unsigned char* Vb = Kb + 32768; \
        _Pragma("unroll") for (int rep = 0; rep < 4; ++rep) { const int it = tid + 512 * rep, chk = it & 15, row = it >> 4; \
            const float dec = __builtin_amdgcn_exp2f(lg2 * (float)(dir ? row : 127 - row)); const u32x4 a = kR[rep]; u32x4 o; \
            o.x = pk2(bflo(a.x) * dec, bfhi(a.x) * dec); o.y = pk2(bflo(a.y) * dec, bfhi(a.y) * dec); o.z = pk2(bflo(a.z) * dec, bfhi(a.z) * dec); o.w = pk2(bflo(a.w) * dec, bfhi(a.w) * dec); \
            *(LAS u32x4*)(Kb + off_b(row, chk)) = o; *(LAS u32x4*)(Vb + off_b(row, chk)) = vR[rep]; } \
        __syncthreads(); \
        RET_ISSUE((s) + 2, kR, vR); \
        _Pragma("unroll") for (int nb = 0; nb < 8; ++nb) acc[nb] = acc[nb] * cd; \
        _Pragma("unroll 1") for (int ks = 0; ks < 4; ++ks) { const bf16x8 A = tr_frag(Kb, 32 * ks + 8 * q, 32 * ks + 8 * q + 4, w, lane); \
            _Pragma("unroll") for (int nb = 0; nb < 8; ++nb) { const bf16x8 B = tr_frag(Vb, 32 * ks + 8 * q, 32 * ks + 8 * q + 4, nb, lane); acc[nb] = __builtin_amdgcn_mfma_f32_16x16x32_bf16(A, B, acc[nb], 0, 0, 0); } } \
        if (!smp && ((s) & (nch - 1)) == nch - 1) {   \
            float* So = p.out + OUT_SRET + (size_t)((seq * 2 + dir) * 8 + h) * 16384; \
            _Pragma("unroll") for (int nb = 0; nb < 8; ++nb) _Pragma("unroll") for (int r = 0; r < 4; ++r) { const int dp = 16 * w + 4 * q + r, d = ((dp & 1) << 6) | (dp >> 1); So[d * 128 + 16 * nb + fr] = acc[nb][r]; } } \
    } while (0)
    RET_ISSUE(0, kA, vA); RET_ISSUE(1, kB, vB);
    for (int s = 0; s < nsteps; s += 2) { RET_STEP(s, kA, vA); RET_STEP(s + 1, kB, vB); }
#undef RET_DECODE
#undef RET_ISSUE
#undef RET_STEP
    __syncthreads();
}

__device__ __forceinline__ void ret_out_unit(const Params& p, LAS unsigned char* lds, int gch, int h, bf16_t* dry, float lgf, float lgb) {
    const int tid = tid_opaque(), lane = tid & 63, w = tid >> 6, q = lane >> 4, fr = lane & 15;
    LAS unsigned char* R0 = lds; LAS unsigned char* R1 = lds + 34816; LAS unsigned char* R2 = lds + 2 * 34816;
    const bool smp = gch >= 64; const int seq = smp ? 32 + ((gch - 64) >> 4) : (gch >> 1); const int ch = smp ? ((gch - 64) & 15) : (gch & 1);
    const size_t row0 = (size_t)gch * 128;
    const bf16_t* Pq = (const bf16_t*)(p.ws + WS_P) + 2 * SLICE_ELEMS; const bf16_t* Pk = Pq + SLICE_ELEMS; const bf16_t* Pv = Pk + SLICE_ELEMS; bf16_t* Pg = (bf16_t*)(p.ws + WS_P) + 5 * SLICE_ELEMS;
    const bf16_t* Sf = (const bf16_t*)(p.ws + WS_H) + (size_t)ret_slot(seq, h, 0, ch) * 16384; const bf16_t* Sb = (const bf16_t*)(p.ws + WS_H) + (size_t)ret_slot(seq, h, 1, ch) * 16384;
    LAS unsigned char* R3 = lds + 3 * 34816;
    u32x4 vreg[4];
#pragma unroll
    for (int rep = 0; rep < 4; ++rep) { const int it = tid + 512 * rep, chk = it & 15, row = it >> 4; const size_t go = (row0 + row) * 1024 + h * 128 + chk * 8;
        *(LAS u32x4*)(R0 + row * 272 + chk * 16) = *(const u32x4*)(Pq + go); *(LAS u32x4*)(R1 + row * 272 + chk * 16) = *(const u32x4*)(Sf + row * 128 + chk * 8); *(LAS u32x4*)(R2 + row * 272 + chk * 16) = *(const u32x4*)(Sb + row * 128 + chk * 8);
        *(LAS u32x4*)(R3 + row * 272 + chk * 16) = *(const u32x4*)(Pk + go); vreg[rep] = *(const u32x4*)(Pv + go); }
    __syncthreads();
    bf16x8 bQ[4];
#pragma unroll
    for (int ks = 0; ks < 4; ++ks) bQ[ks] = row_frag_p(R0, w, ks, lane);
    const int tl = 16 * w + fr;
    const float decf = exp2f(lgf * (float)(tl + 1)), decb = exp2f(lgb * (float)(128 - tl));
    f32x4 o[8];
#pragma unroll
    for (int eb = 0; eb < 8; ++eb) { f32x4 s1 = (f32x4){0.f, 0.f, 0.f, 0.f}, s2 = s1;
#pragma unroll
        for (int ks = 0; ks < 4; ++ks) { s1 = __builtin_amdgcn_mfma_f32_16x16x32_bf16(row_frag_p(R1, eb, ks, lane), bQ[ks], s1, 0, 0, 0); s2 = __builtin_amdgcn_mfma_f32_16x16x32_bf16(row_frag_p(R2, eb, ks, lane), bQ[ks], s2, 0, 0, 0); }
        o[eb] = s1 * decf + s2 * decb; __builtin_amdgcn_sched_barrier(0); }
    __syncthreads();
#pragma unroll
    for (int rep = 0; rep < 4; ++rep) { const int it = tid + 512 * rep, chk = it & 15, row = it >> 4; *(LAS u32x4*)(R2 + off_b(row, chk)) = vreg[rep]; }
    __syncthreads();
    bf16x8 pB[4];
#pragma unroll
    for (int k2 = 0; k2 < 4; ++k2) { f32x4 sa = (f32x4){0.f, 0.f, 0.f, 0.f}, sb = sa;
#pragma unroll
        for (int ks = 0; ks < 4; ++ks) { sa = __builtin_amdgcn_mfma_f32_16x16x32_bf16(row_frag_p(R3, 2 * k2, ks, lane), bQ[ks], sa, 0, 0, 0); sb = __builtin_amdgcn_mfma_f32_16x16x32_bf16(row_frag_p(R3, 2 * k2 + 1, ks, lane), bQ[ks], sb, 0, 0, 0); }
#pragma unroll
        for (int r = 0; r < 4; ++r) { const int da = tl - (32 * k2 + 4 * q + r), db = da - 16;
            sa[r] *= da > 0 ? __builtin_amdgcn_exp2f(lgf * (float)da) : (da < 0 ? __builtin_amdgcn_exp2f(lgb * (float)(-da)) : 2.0f);
            sb[r] *= db > 0 ? __builtin_amdgcn_exp2f(lgf * (float)db) : (db < 0 ? __builtin_amdgcn_exp2f(lgb * (float)(-db)) : 2.0f); }
        u32x4 pk; pk.x = pk2(sa[0], sa[1]); pk.y = pk2(sa[2], sa[3]); pk.z = pk2(sb[0], sb[1]); pk.w = pk2(sb[2], sb[3]);
        pB[k2] = __builtin_bit_cast(bf16x8, pk); __builtin_amdgcn_sched_barrier(0); }
#pragma unroll
    for (int eb = 0; eb < 8; ++eb) {
#pragma unroll
        for (int k2 = 0; k2 < 4; ++k2) { const bf16x8 aV = tr_frag(R2, 32 * k2 + 4 * q, 32 * k2 + 16 + 4 * q, eb, lane); o[eb] = __builtin_amdgcn_mfma_f32_16x16x32_bf16(aV, pB[k2], o[eb], 0, 0, 0); }
        if (eb & 1) __builtin_amdgcn_sched_barrier(0); }
    float ss = 0.f;
#pragma unroll
    for (int eb = 0; eb < 8; ++eb) ss += (o[eb][0] * o[eb][0] + o[eb][1] * o[eb][1]) + (o[eb][2] * o[eb][2] + o[eb][3] * o[eb][3]);
    ss += __shfl_xor(ss, 16); ss += __shfl_xor(ss, 32);
    const float rstd = 1.0f / sqrtf(ss * (1.0f / 128.0f) + EPSV);
#pragma unroll
    for (int eb = 0; eb < 8; ++eb) { const int col = h * 128 + 16 * eb + 4 * q; const size_t off = (row0 + tl) * 1024 + col;
        const f32x4 g = *(const f32x4*)(p.ret_norm_g + col); const u32x2 gt = *(const u32x2*)(Pg + off);
        u32x2 y; y.x = pk2(o[eb][0] * rstd * g[0] * silu(bflo(gt.x)), o[eb][1] * rstd * g[1] * silu(bfhi(gt.x))); y.y = pk2(o[eb][2] * rstd * g[2] * silu(bflo(gt.y)), o[eb][3] * rstd * g[3] * silu(bfhi(gt.y)));
        *(u32x2*)((dry ? dry : Pg) + off) = y; }
    __syncthreads();
}

template <bool FWD>
__device__ __forceinline__ void tile_scan(float (&a)[4][4], float (&b)[4][4], int q, int lane, float& Atot, float& Btot) {
    float As[4], Bs[4], At[4], Bt[4], Ae[4], Be[4];
#pragma unroll
    for (int mb = 0; mb < 4; ++mb) {
        if (FWD) { float A = a[mb][0], B = b[mb][0];
#pragma unroll
            for (int r = 1; r < 4; ++r) { B = B * a[mb][r] + b[mb][r]; A *= a[mb][r]; } As[mb] = A; Bs[mb] = B; }
        else { float A = a[mb][3], B = b[mb][3];
#pragma unroll
            for (int r = 2; r >= 0; --r) { B = B * a[mb][r] + b[mb][r]; A *= a[mb][r]; } As[mb] = A; Bs[mb] = B; }
    }
    const int n1 = FWD ? lane - 16 : lane + 16, n2 = FWD ? lane - 32 : lane + 32;
    const bool v1 = FWD ? (q >= 1) : (q <= 2), v2 = FWD ? (q >= 2) : (q <= 1);
#pragma unroll
    for (int mb = 0; mb < 4; ++mb) {
        const float A1 = __shfl(As[mb], n1), B1 = __shfl(Bs[mb], n1);
        if (v1) { Bs[mb] = B1 * As[mb] + Bs[mb]; As[mb] = A1 * As[mb]; }
        const float A2 = __shfl(As[mb], n2), B2 = __shfl(Bs[mb], n2);
        if (v2) { Bs[mb] = B2 * As[mb] + Bs[mb]; As[mb] = A2 * As[mb]; }
    }
    const int ntot = FWD ? (lane & 15) + 48 : (lane & 15);
#pragma unroll
    for (int mb = 0; mb < 4; ++mb) { At[mb] = __shfl(As[mb], ntot); Bt[mb] = __shfl(Bs[mb], ntot);
        const float ae = __shfl(As[mb], n1), be = __shfl(Bs[mb], n1); Ae[mb] = v1 ? ae : 1.0f; Be[mb] = v1 ? be : 0.0f; }
    float Ac = 1.0f, Bc = 0.0f;
#pragma unroll
    for (int i = 0; i < 4; ++i) { const int mb = FWD ? i : 3 - i;
        float cum = Ac * Ae[mb], hh = Bc * Ae[mb] + Be[mb];
#pragma unroll
        for (int j = 0; j < 4; ++j) { const int r = FWD ? j : 3 - j; hh = a[mb][r] * hh + b[mb][r]; cum = cum * a[mb][r]; b[mb][r] = hh; a[mb][r] = cum; }
        Bc = Bc * At[mb] + Bt[mb]; Ac = Ac * At[mb]; }
    Atot = Ac; Btot = Bc;
}
__device__ __forceinline__ void lru_pass1_phase(const Params& p, LAS unsigned char* lds) {
    const int tid0 = tid_opaque(), G = gridDim.x;
    LAS float* Uf = (LAS float*)lds;
    LAS unsigned char* Ub = lds + 33792;
    LAS unsigned char* Ot = lds + 33792 + 17408;
    const bf16_t* xa = (const bf16_t*)(p.ws + WS_P);
    unsigned xr[11];
#define LRU_LOADX(uu) do { const int gt_ = (uu) >> 3, h_ = (uu) & 7; const int T_ = gt_ < 128 ? 256 : 2048, t0_ = gt_ < 128 ? (gt_ & 3) * 64 : ((gt_ - 128) & 31) * 64; \
        _Pragma("unroll") for (int i = 0; i < 11; ++i) { const int tl = tg * 8 - 2 + i, tt = t0_ + tl; unsigned v = 0u; if (tt >= 0 && tt < T_) v = *(const unsigned*)(xa + (size_t)((long)gt_ * 64 + tl) * 1024 + h_ * 128 + 2 * c2); xr[i] = v; } } while (0)
    int u, ustep, uend;
    if (G == 256) { const int b = blockIdx.x; if (b < 128) { u = b; ustep = 128; uend = 1408; } else { u = 1408 + (b - 128); ustep = 128; uend = 3072; } }
    else { u = blockIdx.x; ustep = G; uend = 3072; }
    { const int c2 = tid0 & 63, tg = tid0 >> 6; if (u < uend) LRU_LOADX(u); }
    bf16x8 bW[4][4];
    LAS float* Cw = (LAS float*)(lds + 103424);
    LAS float* Cl = (LAS float*)(lds + 103424 + 2560);
    int hcur = -1;
    for (; u < uend; u += ustep) {
        int tid = tid0; asm volatile("" : "+v"(tid));
        const int lane = tid & 63, w = tid >> 6, q = lane >> 4, fr = lane & 15, c2 = tid & 63, tg = tid >> 6;
        const int gt = u >> 3, h = u & 7; const size_t row0 = (size_t)gt * 64;
        { const bf16_t* Wg = (const bf16_t*)(p.ws + WS_WG) + (size_t)h * 512 * 128;
#pragma unroll
          for (int g = 0; g < 4; ++g)
#pragma unroll
              for (int ks = 0; ks < 4; ++ks) bW[g][ks] = *(const bf16x8*)(Wg + (size_t)(g * 128 + 16 * w + fr) * 128 + 32 * ks + 8 * q); }
        if (h != hcur) {
            hcur = h; __syncthreads();
            if (tid < 320) { const int j = tid >> 6, cc = 2 * (tid & 63); const float* srcp = (j < 4 ? p.lru_conv_w + j * 1024 : p.lru_conv_b) + h * 128 + cc; *(LAS f32x2*)(Cw + j * 128 + cc) = *(const f32x2*)srcp; }
            if (tid < 256) *(LAS f32x4*)(Cl + tid * 4) = *(const f32x4*)((const float*)(p.ws + WS_LRUC) + h * 1024 + tid * 4);
            __syncthreads(); }
        { const f32x2 w0 = *(const LAS f32x2*)(Cw + 2 * c2), w1 = *(const LAS f32x2*)(Cw + 128 + 2 * c2), w2 = *(const LAS f32x2*)(Cw + 256 + 2 * c2), w3 = *(const LAS f32x2*)(Cw + 384 + 2 * c2), bb = *(const LAS f32x2*)(Cw + 512 + 2 * c2);
#pragma unroll
          for (int j = 0; j < 8; ++j) { const float u0 = w0[0] * bflo(xr[j]) + w1[0] * bflo(xr[j + 1]) + w2[0] * bflo(xr[j + 2]) + w3[0] * bflo(xr[j + 3]) + bb[0];
              const float u1 = w0[1] * bfhi(xr[j]) + w1[1] * bfhi(xr[j + 1]) + w2[1] * bfhi(xr[j + 2]) + w3[1] * bfhi(xr[j + 3]) + bb[1]; const int tl = tg * 8 + j;
              *(LAS f32x2*)(Uf + tl * 132 + 2 * c2) = (f32x2){u0, u1}; *(LAS unsigned*)(Ub + tl * 272 + 4 * c2) = pk2(u0, u1); } }
        if (u + ustep < uend) LRU_LOADX(u + ustep);
        __syncthreads();
        float ga[4][4][4];
        { bf16x8 aU[4][4];
#pragma unroll
          for (int mb = 0; mb < 4; ++mb)
#pragma unroll
              for (int ks = 0; ks < 4; ++ks) aU[mb][ks] = *(const LAS bf16x8*)(Ub + (16 * mb + fr) * 272 + (32 * ks + 8 * q) * 2);
#pragma unroll
          for (int g = 0; g < 4; ++g) {
#pragma unroll
              for (int mb = 0; mb < 4; ++mb) { f32x4 s = (f32x4){0.f, 0.f, 0.f, 0.f};
#pragma unroll
                  for (int ks = 0; ks < 4; ++ks) s = __builtin_amdgcn_mfma_f32_16x16x32_bf16(aU[mb][ks], bW[g][ks], s, 0, 0, 0);
                  ga[g][mb][0] = s[0]; ga[g][mb][1] = s[1]; ga[g][mb][2] = s[2]; ga[g][mb][3] = s[3]; } } }
        const int hc = h * 128 + 16 * w + fr;
        const f32x4 lc0 = *(const LAS f32x4*)(Cl + (16 * w + fr) * 8), lc1 = *(const LAS f32x4*)(Cl + (16 * w + fr) * 8 + 4);
        const float kf = lc0[0], kb = lc0[1], brf = lc0[2], bif = lc0[3], brb = lc1[0], bib = lc1[1];
#pragma unroll
        for (int mb = 0; mb < 4; ++mb)
#pragma unroll
            for (int r = 0; r < 4; ++r) { const float uu = Uf[(16 * mb + 4 * q + r) * 132 + 16 * w + fr];
                const float af = __builtin_amdgcn_exp2f(kf * sigm(ga[0][mb][r] + brf)), bf_ = __builtin_amdgcn_sqrtf(fmaxf(1.0f - af * af, 0.0f)) * sigm(ga[1][mb][r] + bif) * uu;
                const float ab = __builtin_amdgcn_exp2f(kb * sigm(ga[2][mb][r] + brb)), bb_ = __builtin_amdgcn_sqrtf(fmaxf(1.0f - ab * ab, 0.0f)) * sigm(ga[3][mb][r] + bib) * uu;
                ga[0][mb][r] = af; ga[1][mb][r] = bf_; ga[2][mb][r] = ab; ga[3][mb][r] = bb_; }
        float Af, Bf, Ab, Bb;
        tile_scan<true>(ga[0], ga[1], q, lane, Af, Bf);
        tile_scan<false>(ga[2], ga[3], q, lane, Ab, Bb);
#pragma unroll
        for (int mb = 0; mb < 4; ++mb)
#pragma unroll
            for (int r = 0; r < 4; ++r) { const int off = (16 * mb + 4 * q + r) * 272 + (16 * w + fr) * 2;
                *(LAS bf16_t*)(Ot + off) = f2bf(ga[1][mb][r] + ga[3][mb][r]); *(LAS bf16_t*)(Ot + 17408 + off) = f2bf(ga[0][mb][r]); *(LAS bf16_t*)(Ot + 2 * 17408 + off) = f2bf(ga[2][mb][r]); }
        if (q == 0) { float* carr = (float*)(p.ws + WS_CARR);
            *(f32x2*)(carr + ((size_t)(gt * 2 + 0) * 1024 + hc) * 2) = (f32x2){Af, Bf}; *(f32x2*)(carr + ((size_t)(gt * 2 + 1) * 1024 + hc) * 2) = (f32x2){Ab, Bb}; }
        __syncthreads();
        bf16_t* L = (bf16_t*)p.out;
#pragma unroll
        for (int k = 0; k < 6; ++k) { const int idx = tid + 512 * k, tile = idx >> 10, rem = idx & 1023, row = rem >> 4, chk = rem & 15;
            const u32x4 v = *(const LAS u32x4*)(Ot + tile * 17408 + row * 272 + chk * 16);
            *(u32x4*)(L + (size_t)tile * SLICE_ELEMS + (row0 + row) * 1024 + h * 128 + chk * 8) = v; }
        __syncthreads();
    }
#undef LRU_LOADX
}
__device__ __forceinline__ void lru_pass2_unit(const Params& p, int gt, int half, bf16_t* dry) {
    const int tid = tid_opaque(), c8 = half * 512 + (tid & 63) * 8, rg = tid >> 6;
    const bool prm = gt < 128; const int seq = prm ? (gt >> 2) : 32 + ((gt - 128) >> 5); const int ti = prm ? (gt & 3) : ((gt - 128) & 31); const int nT = prm ? 4 : 32; const int gt0 = gt - ti;
    const float* carr = (const float*)(p.ws + WS_CARR);
    float hf[8], hb[8];
#pragma unroll
    for (int j = 0; j < 8; ++j) { hf[j] = 0.f; hb[j] = 0.f; }
    if (!prm) { const f32x4 a0 = *(const f32x4*)(p.state_lru + (size_t)((seq - 32) * 2 + 0) * 1024 + c8), a1 = *(const f32x4*)(p.state_lru + (size_t)((seq - 32) * 2 + 0) * 1024 + c8 + 4);
        const f32x4 b0 = *(const f32x4*)(p.state_lru + (size_t)((seq - 32) * 2 + 1) * 1024 + c8), b1 = *(const f32x4*)(p.state_lru + (size_t)((seq - 32) * 2 + 1) * 1024 + c8 + 4);
#pragma unroll
        for (int j = 0; j < 4; ++j) { hf[j] = a0[j]; hf[4 + j] = a1[j]; hb[j] = b0[j]; hb[4 + j] = b1[j]; } }
#define LRU2_FOLD(hh, cc) do { _Pragma("unroll") for (int j = 0; j < 4; ++j) { hh[2 * j] = cc[j][0] * hh[2 * j] + cc[j][1]; hh[2 * j + 1] = cc[j][2] * hh[2 * j + 1] + cc[j][3]; } } while (0)
    for (int k0 = 0; k0 < ti; k0 += 4) { f32x4 c[4][4];
#pragma unroll
        for (int jj = 0; jj < 4; ++jj) { const int k = (k0 + jj < ti) ? k0 + jj : ti - 1; const float* cp = carr + ((size_t)((gt0 + k) * 2 + 0) * 1024 + c8) * 2;
#pragma unroll
            for (int j = 0; j < 4; ++j) c[jj][j] = *(const f32x4*)(cp + 4 * j); }
#pragma unroll
        for (int jj = 0; jj < 4; ++jj) if (k0 + jj < ti) LRU2_FOLD(hf, c[jj]); }
    for (int k0 = nT - 1; k0 > ti; k0 -= 4) { f32x4 c[4][4];
#pragma unroll
        for (int jj = 0; jj < 4; ++jj) { const int k = (k0 - jj > ti) ? k0 - jj : ti + 1; const float* cp = carr + ((size_t)((gt0 + k) * 2 + 1) * 1024 + c8) * 2;
#pragma unroll
            for (int j = 0; j < 4; ++j) c[jj][j] = *(const f32x4*)(cp + 4 * j); }
#pragma unroll
        for (int jj = 0; jj < 4; ++jj) if (k0 - jj > ti) LRU2_FOLD(hb, c[jj]); }
    if (prm && rg == 0) {
        if (ti == nT - 1) { const float* cp = carr + ((size_t)(gt * 2 + 0) * 1024 + c8) * 2; f32x4 c[4]; float o[8];
#pragma unroll
            for (int j = 0; j < 4; ++j) c[j] = *(const f32x4*)(cp + 4 * j);
#pragma unroll
            for (int j = 0; j < 4; ++j) { o[2 * j] = c[j][0] * hf[2 * j] + c[j][1]; o[2 * j + 1] = c[j][2] * hf[2 * j + 1] + c[j][3]; }
            float* op = p.out + OUT_SLRU + (size_t)(seq * 2 + 0) * 1024 + c8; *(f32x4*)op = (f32x4){o[0], o[1], o[2], o[3]}; *(f32x4*)(op + 4) = (f32x4){o[4], o[5], o[6], o[7]}; }
        if (ti == 0) { const float* cp = carr + ((size_t)(gt * 2 + 1) * 1024 + c8) * 2; f32x4 c[4]; float o[8];
#pragma unroll
            for (int j = 0; j < 4; ++j) c[j] = *(const f32x4*)(cp + 4 * j);
#pragma unroll
            for (int j = 0; j < 4; ++j) { o[2 * j] = c[j][0] * hb[2 * j] + c[j][1]; o[2 * j + 1] = c[j][2] * hb[2 * j + 1] + c[j][3]; }
            float* op = p.out + OUT_SLRU + (size_t)(seq * 2 + 1) * 1024 + c8; *(f32x4*)op = (f32x4){o[0], o[1], o[2], o[3]}; *(f32x4*)(op + 4) = (f32x4){o[4], o[5], o[6], o[7]}; }
    }
#undef LRU2_FOLD
    const bf16_t* L = (const bf16_t*)p.out; bf16_t* Pga = (bf16_t*)(p.ws + WS_P) + SLICE_ELEMS;
#pragma unroll 4
    for (int i = 0; i < 8; ++i) { const size_t off = ((size_t)gt * 64 + rg * 8 + i) * 1024 + c8;
        const u32x4 s = *(const u32x4*)(L + off), af = *(const u32x4*)(L + SLICE_ELEMS + off), ab = *(const u32x4*)(L + 2 * SLICE_ELEMS + off), g = *(const u32x4*)(Pga + off);
        const unsigned sw[4] = {s.x, s.y, s.z, s.w}, fw[4] = {af.x, af.y, af.z, af.w}, bw[4] = {ab.x, ab.y, ab.z, ab.w}, gw[4] = {g.x, g.y, g.z, g.w}; unsigned ow[4];
#pragma unroll
        for (int j = 0; j < 4; ++j) { const float y0 = (bflo(sw[j]) + bflo(fw[j]) * hf[2 * j] + bflo(bw[j]) * hb[2 * j]) * silu(bflo(gw[j])), y1 = (bfhi(sw[j]) + bfhi(fw[j]) * hf[2 * j + 1] + bfhi(bw[j]) * hb[2 * j + 1]) * silu(bfhi(gw[j]));
            ow[j] = pk2(y0, y1); }
        u32x4 o; o.x = ow[0]; o.y = ow[1]; o.z = ow[2]; o.w = ow[3]; *(u32x4*)((dry ? dry : Pga) + off) = o; }
}

__device__ __forceinline__ void sconv_unit(const Params& p, int gt, int half, const float (&w0)[8], const float (&w1)[8], const float (&w2)[8]) {
    const int tid = tid_opaque(), c8 = half * 512 + (tid & 63) * 8, rg = tid >> 6;
    const int T = gt < 128 ? 256 : 2048, t0 = (gt < 128 ? (gt & 3) : ((gt - 128) & 31)) * 64;
    const bf16_t* P = (const bf16_t*)(p.ws + WS_P); const bf16_t* Pv = P + 2 * SLICE_ELEMS; const bf16_t* Pbg = P + 3 * SLICE_ELEMS; bf16_t* Py = (bf16_t*)(p.ws + WS_P) + 5 * SLICE_ELEMS;
    const int tl0 = rg * 8;
    u32x4 vw[10];
#pragma unroll
    for (int i = 0; i < 10; ++i) { const int tl = tl0 - 1 + i, tt = t0 + tl; vw[i] = (u32x4){0u, 0u, 0u, 0u}; if (tt >= 0 && tt < T) vw[i] = *(const u32x4*)(Pv + (size_t)((long)gt * 64 + tl) * 1024 + c8); }
#pragma unroll
    for (int i = 0; i < 8; ++i) { const size_t off = ((size_t)gt * 64 + tl0 + i) * 1024 + c8; const u32x4 g = *(const u32x4*)(Pbg + off);
        const unsigned pw[4] = {vw[i].x, vw[i].y, vw[i].z, vw[i].w}, cw[4] = {vw[i + 1].x, vw[i + 1].y, vw[i + 1].z, vw[i + 1].w}, nw[4] = {vw[i + 2].x, vw[i + 2].y, vw[i + 2].z, vw[i + 2].w}, gw[4] = {g.x, g.y, g.z, g.w}; unsigned ow[4];
#pragma unroll
        for (int j = 0; j < 4; ++j) { const float y0 = bflo(gw[j]) * (w0[2 * j] * bflo(pw[j]) + w1[2 * j] * bflo(cw[j]) + w2[2 * j] * bflo(nw[j])), y1 = bfhi(gw[j]) * (w0[2 * j + 1] * bfhi(pw[j]) + w1[2 * j + 1] * bfhi(cw[j]) + w2[2 * j + 1] * bfhi(nw[j]));
            ow[j] = pk2(y0, y1); }
        u32x4 o; o.x = ow[0]; o.y = ow[1]; o.z = ow[2]; o.w = ow[3]; *(u32x4*)(Py + off) = o; }
}

__device__ __forceinline__ void sconv_phase(const Params& p) {
    const int G = gridDim.x, bid = blockIdx.x, tid = tid_opaque();
    float w0[8], w1[8], w2[8]; int hcur = -1;
    for (int u = bid; u < 768; u += G) { const int half = u & 1;
        if (half != hcur) { hcur = half; const int c8 = half * 512 + (tid & 63) * 8;
#pragma unroll
            for (int j = 0; j < 2; ++j) { const f32x4 a = *(const f32x4*)(p.sconv_w + c8 + 4 * j), b = *(const f32x4*)(p.sconv_w + 1024 + c8 + 4 * j), c = *(const f32x4*)(p.sconv_w + 2048 + c8 + 4 * j);
#pragma unroll
                for (int e = 0; e < 4; ++e) { w0[4 * j + e] = a[e]; w1[4 * j + e] = b[e]; w2[4 * j + e] = c[e]; } } }
        sconv_unit(p, u >> 1, half, w0, w1, w2); }
}

__device__ __forceinline__ void fft8(const float (&xr)[8], const float (&xi)[8], float (&Xr)[8], float (&Xi)[8]) {
    constexpr float R = 0.70710678118654752f;
    const float a0r = xr[0] + xr[4], a0i = xi[0] + xi[4], a1r = xr[0] - xr[4], a1i = xi[0] - xi[4];
    const float a2r = xr[2] + xr[6], a2i = xi[2] + xi[6], a3r = xr[2] - xr[6], a3i = xi[2] - xi[6];
    const float a4r = xr[1] + xr[5], a4i = xi[1] + xi[5], a5r = xr[1] - xr[5], a5i = xi[1] - xi[5];
    const float a6r = xr[3] + xr[7], a6i = xi[3] + xi[7], a7r = xr[3] - xr[7], a7i = xi[3] - xi[7];
    const float b0r = a0r + a2r, b0i = a0i + a2i, b2r = a0r - a2r, b2i = a0i - a2i;
    const float b1r = a1r + a3i, b1i = a1i - a3r, b3r = a1r - a3i, b3i = a1i + a3r;
    const float b4r = a4r + a6r, b4i = a4i + a6i, b6r = a4r - a6r, b6i = a4i - a6i;
    const float b5r = a5r + a7i, b5i = a5i - a7r, b7r = a5r - a7i, b7i = a5i + a7r;
    const float w1r = R * (b5r + b5i), w1i = R * (b5i - b5r), w3r = R * (b7i - b7r), w3i = -R * (b7r + b7i);
    Xr[0] = b0r + b4r; Xi[0] = b0i + b4i; Xr[4] = b0r - b4r; Xi[4] = b0i - b4i;
    Xr[1] = b1r + w1r; Xi[1] = b1i + w1i; Xr[5] = b1r - w1r; Xi[5] = b1i - w1i;
    Xr[2] = b2r + b6i; Xi[2] = b2i - b6r; Xr[6] = b2r - b6i; Xi[6] = b2i + b6r;
    Xr[3] = b3r + w3r; Xi[3] = b3i + w3i; Xr[7] = b3r - w3r; Xi[7] = b3i - w3i;
}
__device__ __forceinline__ void dft8_phase(const Params& p, const bf16_t* PQTs, bf16_t* WQ, int it0, int it1, int blk, int nblk) {
    const int gt = it0 + blk * 512 + tid_opaque(), NT = nblk * 512;
    const float* twc = (const float*)(p.ws + WS_TW) + 256; const float* tws = twc + 2048;
    constexpr float SC = 0.35355339059327373f;
    for (int it = gt; it < it1; it += NT) {
        const int tg = it & 31, jp = (it >> 5) & 1023, b = it >> 15, t0 = tg * 8;
        const bf16_t* row = PQTs + (size_t)(b * 1024 + jp) * 4096;
        unsigned pw[8][4], qw[8][4];
#pragma unroll
        for (int th = 0; th < 8; ++th) { const u32x4 a = *(const u32x4*)(row + t0 + 256 * th), c = *(const u32x4*)(row + 2048 + t0 + 256 * th);
            pw[th][0] = a.x; pw[th][1] = a.y; pw[th][2] = a.z; pw[th][3] = a.w; qw[th][0] = c.x; qw[th][1] = c.y; qw[th][2] = c.z; qw[th][3] = c.w; }
        const f32x4 c1a = *(const f32x4*)(twc + t0), c1b = *(const f32x4*)(twc + t0 + 4), s1a = *(const f32x4*)(tws + t0), s1b = *(const f32x4*)(tws + t0 + 4);
        unsigned outr[8][4], outi[8][4];
#pragma unroll
        for (int wd = 0; wd < 4; ++wd) {
            float yr[2][8], yi[2][8];
#pragma unroll
            for (int hf = 0; hf < 2; ++hf) { const int e = 2 * wd + hf;
                float xr[8], xi[8], Xr[8], Xi[8];
#pragma unroll
                for (int th = 0; th < 8; ++th) { xr[th] = (hf ? bfhi(pw[th][wd]) : bflo(pw[th][wd])) * SC; xi[th] = (hf ? bfhi(qw[th][wd]) : bflo(qw[th][wd])) * (-SC); }
                fft8(xr, xi, Xr, Xi);
                const float c1 = e < 4 ? c1a[e & 3] : c1b[e & 3], s1 = e < 4 ? s1a[e & 3] : s1b[e & 3];
                float wr = 1.f, wi = 0.f;
#pragma unroll
                for (int ka = 0; ka < 8; ++ka) {
                    yr[hf][ka] = Xr[ka] * wr + Xi[ka] * wi; yi[hf][ka] = Xr[ka] * wi - Xi[ka] * wr;
                    const float nr = wr * c1 - wi * s1, ni = wr * s1 + wi * c1; wr = nr; wi = ni; }
            }
#pragma unroll
            for (int ka = 0; ka < 8; ++ka) { outr[ka][wd] = pk2(yr[0][ka], yr[1][ka]); outi[ka][wd] = pk2(yi[0][ka], yi[1][ka]); }
        }
#pragma unroll
        for (int ka = 0; ka < 8; ++ka) { bf16_t* orow = WQ + ((size_t)((b * 8 + ka) * 1024 + jp)) * 512 + t0;
            u32x4 o; o.x = outr[ka][0]; o.y = outr[ka][1]; o.z = outr[ka][2]; o.w = outr[ka][3]; *(u32x4*)orow = o;
            o.x = outi[ka][0]; o.y = outi[ka][1]; o.z = outi[ka][2]; o.w = outi[ka][3]; *(u32x4*)(orow + 256) = o; }
    }
}

__device__ __forceinline__ void final_norm_phase(const Params& p, const bf16_t* X2) {
    const int tid = tid_opaque(), lane = tid & 63, wave = tid >> 6;
    const int nw = gridDim.x * 8, gw = blockIdx.x * 8 + wave, per = (NTOK + nw - 1) / nw, r0 = gw * per, r1 = (r0 + per < NTOK) ? r0 + per : NTOK;
    f32x4 gv[8];
#pragma unroll
    for (int j = 0; j < 8; ++j) gv[j] = *(const f32x4*)(p.final_norm_g + 8 * lane + 512 * (j >> 1) + 4 * (j & 1));
    for (int row = r0; row < r1; ++row) {
        const bf16_t* xr = X2 + (size_t)row * D; float* orow = p.out + (size_t)row * D; f32x4 v[8]; float ss = 0.f;
#pragma unroll
        for (int j = 0; j < 4; ++j) { const u32x4 xv = *(const u32x4*)(xr + 8 * lane + 512 * j); v[2 * j] = (f32x4){bflo(xv.x), bfhi(xv.x), bflo(xv.y), bfhi(xv.y)}; v[2 * j + 1] = (f32x4){bflo(xv.z), bfhi(xv.z), bflo(xv.w), bfhi(xv.w)}; }
#pragma unroll
        for (int j = 0; j < 8; ++j) ss += (v[j][0] * v[j][0] + v[j][1] * v[j][1]) + (v[j][2] * v[j][2] + v[j][3] * v[j][3]);
        const float rstd = 1.0f / sqrtf(wave_sum(ss) * (1.0f / 2048.0f) + EPSV);
#pragma unroll
        for (int j = 0; j < 8; ++j) { const int col = 8 * lane + 512 * (j >> 1) + 4 * (j & 1); *(f32x4*)(orow + col) = v[j] * rstd * gv[j]; }
    }
}

#define XB_TMO      128
#define XB_XCNT(j)  (256  + 64 * (j))
#define XB_XSUB(j)  (1280 + 64 * (j))
#define XB_XGEN(j)  (2304 + 64 * (j))
#define XB_TOP      3328
#define XB_TOPGEN   3392
#define XCD_BAR_WORDS 3456
#define XB_SPIN_CAP (1u << 18)
__device__ __forceinline__ unsigned xb_ld(unsigned* p)              { return __hip_atomic_load(p, __ATOMIC_RELAXED, __HIP_MEMORY_SCOPE_AGENT); }
__device__ __forceinline__ unsigned xb_add(unsigned* p, unsigned v) { return __hip_atomic_fetch_add(p, v, __ATOMIC_RELAXED, __HIP_MEMORY_SCOPE_AGENT); }
__device__ __forceinline__ unsigned xb_xcc_id() { return (unsigned)__builtin_amdgcn_s_getreg((3 << 11) | 20) & 0xFu; }
#define XB_SPIN(cond, bar) do { unsigned _sp = 0; while (cond) { __builtin_amdgcn_s_sleep(1); \
    if ((++_sp & 255u) == 0u) { if (xb_ld(&(bar)[XB_TMO])) break; if (_sp > XB_SPIN_CAP) { atomicAdd(&(bar)[XB_TMO], 1u); break; } } } } while (0)
struct XcdBarrier { unsigned* bar; unsigned x; volatile LAS unsigned* st; };
__device__ __forceinline__ XcdBarrier xcd_barrier_post(unsigned* bar, volatile LAS unsigned* st) {
    XcdBarrier b; b.bar = bar; b.x = xb_xcc_id(); b.st = st;
    if (threadIdx.x == 0) (void)xb_add(&bar[XB_XCNT(b.x)], 1u);
    return b;
}
__device__ __forceinline__ void xcd_barrier_complete(unsigned* bar, unsigned x, unsigned& nloc, unsigned& nx) {
    const unsigned G = gridDim.x * gridDim.y * gridDim.z;
    unsigned sum, cnt, mine, sp = 0u;
    for (;;) {
        sum = 0u; cnt = 0u; mine = 0u;
#pragma unroll
        for (unsigned j = 0; j < 16; ++j) { const unsigned c = xb_ld(&bar[XB_XCNT(j)]); sum += c; cnt += (c > 0u) ? 1u : 0u; mine = (j == x) ? c : mine; }
        if (sum == G) break;
        __builtin_amdgcn_s_sleep(1);
        if ((++sp & 255u) == 0u) { if (xb_ld(&bar[XB_TMO])) break; if (sp > XB_SPIN_CAP) { atomicAdd(&bar[XB_TMO], 1u); break; } }
    }
    nloc = mine > 0u ? mine : 1u; nx = cnt > 0u ? cnt : 1u;
}
__device__ __forceinline__ void xcd_barrier(const XcdBarrier& b) {
    asm volatile("s_waitcnt vmcnt(0)" ::: "memory");
    __syncthreads();
    if (threadIdx.x == 0) {
        unsigned* bar = b.bar;
        __builtin_amdgcn_s_waitcnt(0);
        unsigned nloc = b.st[0], nx = b.st[1];
        if (nloc == 0u) { xcd_barrier_complete(bar, b.x, nloc, nx); b.st[0] = nloc; b.st[1] = nx; }
        const unsigned old = xb_add(&bar[XB_XSUB(b.x)], 1u);
        const unsigned gen = old / nloc;
        if (old + 1u == (gen + 1u) * nloc) {
            __builtin_amdgcn_fence(__ATOMIC_RELEASE, "agent");
            asm volatile("s_waitcnt vmcnt(0)" ::: "memory");
            const unsigned og = xb_add(&bar[XB_TOP], 1u);
            const unsigned tg = og / nx;
            if (og + 1u == (tg + 1u) * nx) xb_add(&bar[XB_TOPGEN], 1u);
            else XB_SPIN(xb_ld(&bar[XB_TOPGEN]) == tg, bar);
            __builtin_amdgcn_fence(__ATOMIC_ACQUIRE, "agent");
            xb_add(&bar[XB_XGEN(b.x)], 1u);
            asm volatile("s_waitcnt vmcnt(0)" ::: "memory");
        } else {
            XB_SPIN(xb_ld(&bar[XB_XGEN(b.x)]) == gen, bar);
            __builtin_amdgcn_fence(__ATOMIC_ACQUIRE, "agent");
            asm volatile("s_waitcnt vmcnt(0)" ::: "memory");
        }
    }
    __syncthreads();
}

constexpr int NPH = 13;
__global__ void __launch_bounds__(512, 2) mk_fwd(Params p) {
    extern __shared__ __attribute__((aligned(16))) unsigned char lds_raw[];
    LAS unsigned char* lds = (LAS unsigned char*)lds_raw;
    const int G = gridDim.x, bid = blockIdx.x;
#define IN(k) (p.ph_lo <= (k) && (k) < p.ph_hi)
    volatile LAS unsigned* MISC = (volatile LAS unsigned*)(lds + LDS_BYTES - 16);
    if (threadIdx.x < 4) MISC[threadIdx.x] = 0u;
    __syncthreads();
    const XcdBarrier xbar = xcd_barrier_post((unsigned*)(p.ws + WS_CTL) + p.li * 4096, MISC);
#define SEAM(k) do { if (IN(k) && IN((k) + 1)) { if (p.ph_lo > 1000) cg::this_grid().sync(); else xcd_barrier(xbar); } } while (0)
    const char* Hb = (const char*)(p.ws + WS_H);
    bf16_t* Pb = (bf16_t*)(p.ws + WS_P);
    const float* mod = (const float*)(p.ws + WS_MOD);
    bf16_t* X1B = (bf16_t*)(p.ws + WS_H);
    bf16_t* H1 = (bf16_t*)p.out;
    bf16_t* WQB = (bf16_t*)p.out + (size_t)NTOK * 2048;
    bf16_t* X2B = Pb + 2 * SLICE_ELEMS;

    if (IN(0)) ph0_prep(p, lds);
    SEAM(0);
    if (IN(1)) normmod_phase<false>(p, p.x_prompt, p.x_sample - (size_t)NPR * D, 0, (bf16_t*)(p.ws + WS_H));
    SEAM(1);
    if (IN(2)) { pg8::GCfg g{2048, 2048, 32, 1 << 30, 0l, SKEW_IN}; pg8::SchedInProj S{Hb, (const char*)(p.ws + WS_WIN), G, bid, p.pad}; pg8::EpiInProjL0 E{Pb, (const float*)(p.ws + WS_ROPE), (const float*)(p.ws + WS_ROPE) + 2048 * 64, p.pad & (32 | 256)};
        pg8::gemm_phase<true>(lds, g, S, E); }
    SEAM(2);
    if (IN(3)) {
        if (!(p.pad & 1)) {
            if (G == 256) {
                if (bid < 128) ret_chain_stream(p, lds, bid, 1); else ret_chain_stream(p, lds, 128 + (bid - 128) * 4, 4);
            } else { for (int ci = bid; ci < 128; ci += G) ret_chain_stream(p, lds, ci, 1); for (int ci = bid; ci < 512; ci += G) ret_chain_stream(p, lds, 128 + ci, 1); }
        }
        if (!(p.pad & 2)) lru_pass1_phase(p, lds);
        if (!(p.pad & 512)) prep_layer1(p, lds);
    }
    SEAM(3);
    if (IN(4)) {
        bf16_t* dry = (p.pad & 16) ? (bf16_t*)p.out + 3 * SLICE_ELEMS : nullptr;
        const bool lfirst = ((bid >> 3) & 1) != 0;
        if (lfirst && !(p.pad & 8)) for (int u = bid; u < 768; u += G) lru_pass2_unit(p, u >> 1, u & 1, dry);
        if (!(p.pad & 4)) { int hc_ = -1; float lgf_ = 0.f, lgb_ = 0.f;
            for (int u = bid; u < 1536; u += G) { const int h_ = u & 7; if (h_ != hc_) { hc_ = h_; lgf_ = -log1pf(expf(-p.ret_decay[h_])) * LOG2E; lgb_ = -log1pf(expf(-p.ret_decay[8 + h_])) * LOG2E; }
                ret_out_unit(p, lds, u >> 3, h_, dry, lgf_, lgb_); } }
        if (!lfirst && !(p.pad & 8)) for (int u = bid; u < 768; u += G) lru_pass2_unit(p, u >> 1, u & 1, dry);
    }
    SEAM(4);
    if (IN(5)) { pg8::GCfg g{1024, 2048, 32, 16, (long)(4 * SLICE_ELEMS * 2) - 2048l, SKEW_OUT}; pg8::SchedOutProj S{(const char*)(Pb + SLICE_ELEMS), (const char*)(p.ws + WS_WOUT), G, bid};
        pg8::EpiResidB<false> E{p.x_prompt, p.x_sample - (size_t)NPR * D, X1B, mod + 4096};
        pg8::gemm_phase<true>(lds, g, S, E); }
    SEAM(5);
    if (IN(6)) normmod_phase<true>(p, X1B, X1B, 1, H1);
    SEAM(6);
    if (IN(7)) { pg8::GCfg g{2048, 2048, 32, 1 << 30, 0l, SKEW_IN}; pg8::SchedInProjL1 S{(const char*)H1, (const char*)(p.ws + WS_WIN) + (size_t)6144 * 2048 * 2, G, bid}; pg8::EpiInProjL1 E{Pb};
        pg8::gemm_phase<true>(lds, g, S, E); }
    SEAM(7);
    if (IN(8)) {
        bf16_t* PQT = H1;
        const bool sfirst = ((bid >> 3) & 1) != 0;
        if (sfirst) sconv_phase(p);
        { pg8::GCfg g{256, 1024, 4, 1 << 30, 0l, SKEW_F1}; pg8::SchedF1 S{(const char*)(p.ws + WS_TAB1), (const char*)(Pb + (size_t)NPR * 1024), G, bid, 2048, 8, (long)32 * 1024 * 512}; pg8::EpiBf16Store E{PQT, 4096};
          pg8::gemm_phase<false>(lds, g, S, E); }
        { pg8::GCfg g{256, 1024, 4, 1 << 30, 0l, SKEW_F1}; pg8::SchedF1 S{(const char*)(p.ws + WS_TAB1), (const char*)Pb, G, bid, 256, 32, 0l}; pg8::EpiBf16Store E{PQT, 512};
          pg8::gemm_phase<false>(lds, g, S, E); }
        if (!sfirst) sconv_phase(p);
    }
    SEAM(8);
    if (IN(9)) {
        const bool gfirst = bid >= G / 2;
        if (gfirst) { pg8::GCfg g{512, 512, 8, 1 << 30, 0l, 0}; pg8::SchedF2 S{(const char*)(p.ws + WS_TAB2P), (const char*)WQB, (const char*)H1, G / 2, bid - G / 2, 256, 384}; pg8::EpiSiluInPlace E{Pb}; pg8::gemm_phase<true>(lds, g, S, E); }
        constexpr int NIT = 8 * 1024 * 32, SPLIT = (NIT * 65 / 100) & ~511;
        if (G >= 2 && (G & 1) == 0) { if (gfirst) dft8_phase(p, H1 + (size_t)32 * 1024 * 512, WQB, SPLIT, NIT, bid - G / 2, G / 2); else dft8_phase(p, H1 + (size_t)32 * 1024 * 512, WQB, 0, SPLIT, bid, G / 2); }
        else dft8_phase(p, H1 + (size_t)32 * 1024 * 512, WQB, 0, NIT, bid, G);
    }
    SEAM(9);
    if (IN(10)) { pg8::GCfg g{512, 512, 8, 1 << 30, 0l, 0}; pg8::SchedF2 S{(const char*)(p.ws + WS_TAB2P), (const char*)WQB, (const char*)H1, G, bid, 0, 256}; pg8::EpiSiluInPlace E{Pb};
        pg8::gemm_phase<true>(lds, g, S, E); }
    SEAM(10);
    if (IN(11)) { pg8::GCfg g{1024, 2048, 32, 16, (long)(4 * SLICE_ELEMS * 2) - 2048l, SKEW_OUT}; pg8::SchedOutProj S{(const char*)(Pb + SLICE_ELEMS), (const char*)(p.ws + WS_WOUT) + (size_t)2048 * 2048 * 2, G, bid};
        pg8::EpiResidB<true> E{X1B, X1B, X2B, mod + 9 * 6144 + 4096};
        pg8::gemm_phase<true>(lds, g, S, E); }
    SEAM(11);
    if (IN(12)) final_norm_phase(p, X2B);
#undef IN
#undef SEAM
}

extern "C" void kernel_launch(void* const* d_in, const int* in_sizes, int n_in, void* d_out, int out_size, void* d_ws, size_t ws_size, hipStream_t stream) {
    static int grid = 0;
    if (grid == 0) {
        int dev = 0, cus = 0, per_cu = 0;
        if (n_in != 22 || ws_size < WS_END) { fprintf(stderr, "kernel_launch: unexpected n_in %d / ws_size %zu (need %zu)\n", n_in, ws_size, (size_t)WS_END); grid = -1; return; }
        (void)hipGetDevice(&dev); (void)hipDeviceGetAttribute(&cus, hipDeviceAttributeMultiprocessorCount, dev);
        if (hipFuncSetAttribute((const void*)mk_fwd, hipFuncAttributeMaxDynamicSharedMemorySize, LDS_BYTES) != hipSuccess) { fprintf(stderr, "kernel_launch: hipFuncSetAttribute failed\n"); grid = -1; return; }
        if (hipOccupancyMaxActiveBlocksPerMultiprocessor(&per_cu, (const void*)mk_fwd, 512, LDS_BYTES) != hipSuccess || per_cu < 1) { fprintf(stderr, "kernel_launch: occupancy query says %d blocks per CU\n", per_cu); (void)hipGetLastError(); per_cu = 1; }
        grid = cus;
        (void)per_cu;
    }
    if (grid < 0) return;
    Params p{};
    const float** pp = (const float**)&p;
    for (int i = 0; i < 22; ++i) pp[i] = (const float*)d_in[i];
    p.out = (float*)d_out; p.ws = (unsigned char*)d_ws;
    if (hipMemsetAsync((char*)d_ws + WS_CTL, 0, 65536, stream) != hipSuccess) { fprintf(stderr, "kernel_launch: hipMemsetAsync failed\n"); return; }
#if MK_PER_PHASE_LAUNCH
    for (int ph = 0; ph < NPH; ++ph) { p.ph_lo = ph; p.ph_hi = ph + 1; hipLaunchKernelGGL(mk_fwd, dim3(grid), dim3(512), LDS_BYTES, stream, p); }
#else
    int plo[3] = {0, 0, 0}, phi[3] = {NPH, 0, 0}, pfl[3] = {0, 0, 0}; int nl = 1;
    if (MK_PROBE >= 100) { nl = 2; phi[0] = MK_PROBE - 100 + 1; plo[1] = MK_PROBE - 100; phi[1] = NPH; }
    if (MK_PROBE == 21) { nl = 2; phi[0] = 3; plo[1] = 2; phi[1] = NPH; pfl[1] = 32; }
    if (MK_PROBE == 23) { nl = 3; phi[0] = 3; plo[1] = 2; phi[1] = 3; pfl[1] = 32 | 64 | 128; plo[2] = 3; phi[2] = NPH; }
    if (MK_PROBE == 25) { nl = 3; phi[0] = 3; plo[1] = 2; phi[1] = 3; pfl[1] = 256; plo[2] = 3; phi[2] = NPH; }
    if (MK_PROBE == 26) { nl = 3; phi[0] = 3; plo[1] = 2; phi[1] = 3; pfl[1] = 0; plo[2] = 3; phi[2] = NPH; }
    if (MK_PROBE == 24) { nl = 3; phi[0] = 3; plo[1] = 2; phi[1] = 3; pfl[1] = 32; plo[2] = 3; phi[2] = NPH; }
    if (MK_PROBE == 31 || MK_PROBE == 32) { nl = 2; phi[0] = 4; plo[1] = 3; phi[1] = NPH; pfl[1] = (MK_PROBE == 31 ? 2 : 1) | 512; }
    if (MK_PROBE == 33) { nl = 2; phi[0] = 4; plo[1] = 3; phi[1] = NPH; pfl[1] = 3; }
    if (MK_PROBE == 34) { nl = 2; phi[0] = 4; plo[1] = 3; phi[1] = NPH; pfl[1] = 3 | 512; }
    if (MK_PROBE == 41 || MK_PROBE == 42) { nl = 3; phi[0] = 4; plo[1] = 4; phi[1] = 5; pfl[1] = 16 | (MK_PROBE == 41 ? 8 : 4); plo[2] = 4; phi[2] = NPH; }
    for (int li = 0; li < nl; ++li) {
        p.ph_lo = plo[li]; p.ph_hi = phi[li]; p.li = li; p.pad = pfl[li];
        void* args[] = {&p};
        hipError_t e = hipLaunchCooperativeKernel((const void*)mk_fwd, dim3(grid), dim3(512), args, LDS_BYTES, stream);
        if (e != hipSuccess) fprintf(stderr, "kernel_launch: cooperative launch failed: %s (grid %d)\n", hipGetErrorString(e), grid);
    }
#endif
}
```
